# Optimizing an MI355X kernel written in HIP

```python
import jax, jax.numpy as jnp
from jax import lax
import numpy as np

D_MODEL = 1024
BATCH = 1
SEQ = 16384
DEPTH = 2

N_META = 16
N_HEADS = 16
N_KV_HEADS = 4
HEAD_DIM = 64
GQA_GROUP = N_HEADS // N_KV_HEADS
WINDOW = 128
BLOCK = 128
FRONT_PAD = (-N_META) % BLOCK
POOL_WINDOWS = (2, 4, 8, 16)
N_POOL_GROUPS = len(POOL_WINDOWS)
POOL_GROUP_DIM = D_MODEL // 8
POOL_DIM = N_POOL_GROUPS * POOL_GROUP_DIM
Q_DIM = N_HEADS * HEAD_DIM
KV_DIM = N_KV_HEADS * HEAD_DIM
IN_COLS = POOL_DIM + Q_DIM + 2 * KV_DIM + 2 * D_MODEL
SPLITS = [POOL_DIM, POOL_DIM + Q_DIM, POOL_DIM + Q_DIM + KV_DIM,
          POOL_DIM + Q_DIM + 2 * KV_DIM, POOL_DIM + Q_DIM + 2 * KV_DIM + D_MODEL]
D_FF = ((8 * D_MODEL // 3 + 127) // 128) * 128
RMS_EPS = 1e-6
NEG_INF = -1e30
FFN1_PRE, FFN1_POST, MIX_PRE, MIX_POST, FFN2_PRE, FFN2_POST = range(6)

kernel_name = "hybrid_pool_swa_gated_macaron"


def rmsnorm(x, g):
    xf = x.astype(jnp.float32)
    y = xf * lax.rsqrt(jnp.mean(xf * xf, axis=-1, keepdims=True) + RMS_EPS)
    return (y * g.astype(jnp.float32)).astype(x.dtype)


def swiglu(x, w_in, w_out):
    gate, up = jnp.split(x @ w_in, 2, axis=-1)
    return (jax.nn.silu(gate) * up) @ w_out


def alibi_slopes():
    m = 2.0 ** (-8.0 * np.arange(1, N_HEADS + 1) / N_HEADS)
    return jnp.asarray(m, dtype=jnp.float32).reshape(N_KV_HEADS, GQA_GROUP)


def pool_mixer(u, w_grp, scale, w_proj):
    B, L, _ = u.shape
    ug = u.reshape(B, L, N_POOL_GROUPS, POOL_GROUP_DIM)
    cs = jnp.cumsum(ug.astype(jnp.float32), axis=1)
    cs = jnp.pad(cs, ((0, 0), (1, 0), (0, 0), (0, 0)))
    t1 = jnp.arange(1, L + 1, dtype=jnp.int32)[:, None]
    win = jnp.asarray(POOL_WINDOWS, dtype=jnp.int32)[None, :]
    lag = jnp.maximum(t1 - win, 0)
    lagged = cs[:, lag, jnp.arange(N_POOL_GROUPS)[None, :], :]
    count = jnp.minimum(t1, win).astype(jnp.float32)
    pooled = (cs[:, 1:] - lagged) / count[None, :, :, None]
    mixed = (pooled - ug.astype(jnp.float32)).astype(u.dtype)
    mixed = jnp.einsum('blgc,gcd->blgd', mixed, w_grp).reshape(B, L, POOL_DIM) * scale
    return mixed @ w_proj


def swa_attention(q, k, v, sinks):
    B, L = q.shape[0], q.shape[1]
    Lp = L + FRONT_PAD
    nb = Lp // BLOCK
    padf = lambda a: jnp.pad(a, ((0, 0), (FRONT_PAD, 0), (0, 0), (0, 0)))
    qb = padf(q).reshape(B, nb, BLOCK, N_KV_HEADS, GQA_GROUP, HEAD_DIM)
    kb = padf(k).reshape(B, nb, BLOCK, N_KV_HEADS, HEAD_DIM)
    vb = padf(v).reshape(B, nb, BLOCK, N_KV_HEADS, HEAD_DIM)
    shift = lambda a: jnp.concatenate([jnp.zeros_like(a[:, :1]), a[:, :-1]], axis=1)
    kk = jnp.concatenate([shift(kb), kb], axis=2)
    vv = jnp.concatenate([shift(vb), vb], axis=2)
    k_meta, v_meta = k[:, :N_META], v[:, :N_META]
    scale = HEAD_DIM ** -0.5
    s_band = jnp.einsum('bnqkgd,bnskd->bnkgqs', qb, kk,
                        preferred_element_type=jnp.float32) * scale
    s_meta = jnp.einsum('bnqkgd,bmkd->bnkgqm', qb, k_meta,
                        preferred_element_type=jnp.float32) * scale
    q_pos = jnp.arange(Lp, dtype=jnp.int32).reshape(nb, BLOCK)
    k_pos = (jnp.arange(nb, dtype=jnp.int32)[:, None] - 1) * BLOCK + jnp.arange(2 * BLOCK, dtype=jnp.int32)[None, :]
    dist = q_pos[:, :, None] - k_pos[:, None, :]
    band_ok = (dist >= 0) & (dist < WINDOW) & (k_pos[:, None, :] >= FRONT_PAD)
    alibi_d = jnp.where(k_pos[:, None, :] >= FRONT_PAD + N_META, dist, 0).astype(jnp.float32)
    slopes = alibi_slopes()
    bias_band = jnp.where(band_ok[:, None, None],
                          -slopes[None, :, :, None, None] * alibi_d[:, None, None],
                          NEG_INF)
    s_band = s_band + bias_band[None]
    meta_pos = FRONT_PAD + jnp.arange(N_META, dtype=jnp.int32)
    meta_ok = (q_pos[:, :, None] - meta_pos[None, None, :]) >= WINDOW
    s_meta = jnp.where(meta_ok[None, :, None, None], s_meta, NEG_INF)
    sink = sinks.astype(jnp.float32).reshape(N_KV_HEADS, GQA_GROUP)[None, None, :, :, None, None]
    sink = jnp.broadcast_to(sink, s_band.shape[:-1] + (1,))
    logits = jnp.concatenate([s_band, s_meta, sink], axis=-1)
    probs = jax.nn.softmax(logits, axis=-1).astype(v.dtype)
    p_band = probs[..., :2 * BLOCK]
    p_meta = probs[..., 2 * BLOCK:2 * BLOCK + N_META]
    out = (jnp.einsum('bnkgqs,bnskd->bnqkgd', p_band, vv)
           + jnp.einsum('bnkgqm,bmkd->bnqkgd', p_meta, v_meta))
    return out.reshape(B, Lp, Q_DIM)[:, FRONT_PAD:]


def setup_inputs(seed: int = 0) -> dict:
    key = jax.random.key(seed)
    ks = jax.random.split(key, 13)
    nrm = lambda k, shape, fan_in: jax.random.normal(k, shape, jnp.float32) * (fan_in ** -0.5)
    x = jax.random.normal(ks[0], (BATCH, SEQ, D_MODEL), jnp.float32)
    meta_tokens = jax.random.normal(ks[1], (N_META, D_MODEL), jnp.float32)
    norm_g = 1.0 + 0.05 * jax.random.normal(ks[2], (DEPTH, 6, D_MODEL), jnp.float32)
    ffn_w_in = nrm(ks[3], (DEPTH, 2, D_MODEL, 2 * D_FF), D_MODEL)
    ffn_w_out = nrm(ks[4], (DEPTH, 2, D_FF, D_MODEL), D_FF)
    w_in = nrm(ks[5], (DEPTH, D_MODEL, IN_COLS), D_MODEL)
    pool_w_grp = nrm(ks[6], (DEPTH, N_POOL_GROUPS, POOL_GROUP_DIM, POOL_GROUP_DIM), POOL_GROUP_DIM)
    pool_scale = 1.0 + 0.05 * jax.random.normal(ks[7], (DEPTH, POOL_DIM), jnp.float32)
    w_pool_proj = nrm(ks[8], (DEPTH, POOL_DIM, D_MODEL), POOL_DIM)
    sinks = 0.5 * jax.random.normal(ks[9], (DEPTH, N_HEADS), jnp.float32)
    w_attn_proj = nrm(ks[10], (DEPTH, Q_DIM, D_MODEL), Q_DIM)
    w_o = nrm(ks[11], (DEPTH, D_MODEL, D_MODEL), D_MODEL)
    return {"x": x, "meta_tokens": meta_tokens, "norm_g": norm_g,
            "ffn_w_in": ffn_w_in, "ffn_w_out": ffn_w_out, "w_in": w_in,
            "pool_w_grp": pool_w_grp, "pool_scale": pool_scale,
            "w_pool_proj": w_pool_proj, "sinks": sinks,
            "w_attn_proj": w_attn_proj, "w_o": w_o}


def reference(x, meta_tokens, norm_g, ffn_w_in, ffn_w_out, w_in, pool_w_grp,
              pool_scale, w_pool_proj, sinks, w_attn_proj, w_o):
    B = x.shape[0]
    meta = jnp.broadcast_to(meta_tokens.astype(x.dtype)[None], (B, N_META, D_MODEL))
    h = jnp.concatenate([meta, x], axis=1)
    L = h.shape[1]
    for l in range(DEPTH):
        g = norm_g[l]
        h = h + 0.5 * rmsnorm(swiglu(rmsnorm(h, g[FFN1_PRE]), ffn_w_in[l, 0], ffn_w_out[l, 0]), g[FFN1_POST])
        hn = rmsnorm(h, g[MIX_PRE])
        u_pool, q, k, v, gate_pool, gate_attn = jnp.split(hn @ w_in[l], SPLITS, axis=-1)
        y_pool = pool_mixer(u_pool, pool_w_grp[l], pool_scale[l], w_pool_proj[l])
        attn = swa_attention(q.reshape(B, L, N_HEADS, HEAD_DIM),
                             k.reshape(B, L, N_KV_HEADS, HEAD_DIM),
                             v.reshape(B, L, N_KV_HEADS, HEAD_DIM), sinks[l])
        y_attn = attn @ w_attn_proj[l]
        merged = jax.nn.sigmoid(gate_pool) * y_pool + jax.nn.sigmoid(gate_attn) * y_attn
        h = h + rmsnorm(merged @ w_o[l], g[MIX_POST])
        h = h + 0.5 * rmsnorm(swiglu(rmsnorm(h, g[FFN2_PRE]), ffn_w_in[l, 1], ffn_w_out[l, 1]), g[FFN2_POST])
    return h[:, N_META:]
```

```cpp
#include <hip/hip_runtime.h>
#include <hip/hip_cooperative_groups.h>
#include <cstdio>
#include <cstdint>
namespace cg = cooperative_groups;
namespace pg8 {
#define PG8_LAS __attribute__((address_space(3)))
typedef unsigned short bf16_t;
typedef short bf16x8 __attribute__((ext_vector_type(8)));
typedef float f32x4 __attribute__((ext_vector_type(4)));
typedef unsigned u32x4 __attribute__((ext_vector_type(4)));
constexpr int BM = 256, BK = 64, HALF = 128, HTB = HALF * BK * 2  , STAGE_BYTES = 8 * HTB, NXCD = 8, WGM = 8;

__host__ __device__ __forceinline__ int lds_byte(int r, int c) { const int st = (r >> 4) * 2 + (c >> 5), rr = r & 15, cc = c & 31, ob = rr * 64 + cc * 2; return st * 1024 + (ob ^ (((ob >> 9) & 1) << 5)); }
__host__ __device__ __forceinline__ void stage_rc(int b, int& R, int& C) { const int st = b / 1024, sb = b % 1024, swz = sb ^ (((sb >> 9) & 1) << 5); R = (st >> 1) * 16 + swz / 64; C = (st & 1) * 32 + (swz % 64) / 2; }
__host__ __device__ __forceinline__ int perm32(int rho) { const int n = rho >> 4, i = rho & 15; return 8 * (i >> 2) + 4 * n + (i & 3); }

struct Unit { int pm, pn; };
struct Gemm { const bf16_t* A; const bf16_t* Bt; int M, N, K; };

struct StaticOrder {
    int nM, nN, nwg, G, c;
    __host__ __device__ void init(int M, int N, int G_, int c_) { nM = M / BM; nN = N / BM; nwg = nM * nN; G = G_; c = c_; }
    __host__ __device__ bool next(int i, Unit& u) const {
        const long L = (long)i * G + c; if (L >= nwg) return false;
        int wgid = (int)L; { const int q = nwg / NXCD, r = nwg % NXCD, xcd = wgid % NXCD, off = wgid / NXCD; wgid = (xcd < r ? xcd * (q + 1) : r * (q + 1) + (xcd - r) * q) + off; }
        const int nig = WGM * nN, gid = wgid / nig, fm = gid * WGM, gsz = (nM - fm) < WGM ? (nM - fm) : WGM;
        u.pm = fm + ((wgid % nig) % gsz); u.pn = (wgid % nig) / gsz; return true;
    }
    __device__ __forceinline__ void a_ready(const Unit&) const {}
    __device__ __forceinline__ void done(const Unit&) const {}
};
__device__ __forceinline__ unsigned cvt_pk_bf16(float lo, float hi) { unsigned r; asm volatile("v_cvt_pk_bf16_f32 %0, %1, %2" : "=v"(r) : "v"(lo), "v"(hi)); return r; }
typedef float f32x2 __attribute__((ext_vector_type(2)));
typedef unsigned u32x2 __attribute__((ext_vector_type(2)));
__device__ __forceinline__ float bf2f(unsigned short b) { return __uint_as_float(((unsigned)b) << 16); }
__device__ __forceinline__ float sigmoidf_fast(float x) { return __builtin_amdgcn_rcpf(1.0f + __builtin_amdgcn_exp2f(-1.4426950408889634f * x)); }
__device__ __forceinline__ float silu_mul(float g, float u) { return g * sigmoidf_fast(g) * u; }

struct EpiF32 {
    static constexpr bool PERM = false, AFTER_DRAIN = false;
    float* C; int ldc;
    __device__ __forceinline__ void operator()(const f32x4 (&acc)[2][2][4][2], const Unit& u, int wr, int wc, int fr, int fq) const {
        const int row0 = u.pm * BM + wr * 64 + fr, col0 = u.pn * BM + wc * 32 + 4 * fq;
#pragma unroll
        for (int ai = 0; ai < 2; ++ai)
#pragma unroll
            for (int m = 0; m < 4; ++m) { float* rowp = C + (size_t)(row0 + ai * HALF + m * 16) * ldc + col0;
#pragma unroll
                for (int bj = 0; bj < 2; ++bj)
#pragma unroll
                    for (int n = 0; n < 2; ++n) *(f32x4*)(rowp + bj * HALF + n * 16) = acc[ai][bj][m][n]; }
    }
};
struct EpiSwiglu {
    static constexpr bool PERM = true, AFTER_DRAIN = false;
    bf16_t* G; int ldc;
    __device__ __forceinline__ void operator()(const f32x4 (&acc)[2][2][4][2], const Unit& u, int wr, int wc, int fr, int fq) const {
        const int row0 = u.pm * BM + wr * 64 + fr, col0 = u.pn * HALF + wc * 32 + 8 * fq;
#pragma unroll
        for (int ai = 0; ai < 2; ++ai)
#pragma unroll
            for (int m = 0; m < 4; ++m) { bf16_t* rowp = G + (size_t)(row0 + ai * HALF + m * 16) * ldc + col0;
                const f32x4 g0 = acc[ai][0][m][0], g1 = acc[ai][0][m][1], u0 = acc[ai][1][m][0], u1 = acc[ai][1][m][1];
                u32x4 w;
                w.x = cvt_pk_bf16(silu_mul(g0[0], u0[0]), silu_mul(g0[1], u0[1]));
                w.y = cvt_pk_bf16(silu_mul(g0[2], u0[2]), silu_mul(g0[3], u0[3]));
                w.z = cvt_pk_bf16(silu_mul(g1[0], u1[0]), silu_mul(g1[1], u1[1]));
                w.w = cvt_pk_bf16(silu_mul(g1[2], u1[2]), silu_mul(g1[3], u1[3]));
                *(u32x4*)rowp = w; }
    }
};
struct EpiWin {
    static constexpr bool PERM = true, AFTER_DRAIN = false;
    bf16_t *U, *Q, *Kb, *Vb, *GP, *GA; float qscale;
    __device__ __forceinline__ void operator()(const f32x4 (&acc)[2][2][4][2], const Unit& u, int wr, int wc, int fr, int fq) const {
        bf16_t* base; int ldc, ct; float sc = 1.f; const int pn = u.pn;
        if (pn < 2) { base = U; ldc = 512; ct = pn; }
        else if (pn < 6) { base = Q; ldc = 1024; ct = pn - 2; sc = qscale; }
        else if (pn == 6) { base = Kb; ldc = 256; ct = 0; }
        else if (pn == 7) { base = Vb; ldc = 256; ct = 0; }
        else if (pn < 12) { base = GP; ldc = 1024; ct = pn - 8; }
        else { base = GA; ldc = 1024; ct = pn - 12; }
        const int row0 = u.pm * BM + wr * 64 + fr, col0 = ct * BM + wc * 32 + 8 * fq;
#pragma unroll
        for (int ai = 0; ai < 2; ++ai)
#pragma unroll
            for (int m = 0; m < 4; ++m) { bf16_t* rowp = base + (size_t)(row0 + ai * HALF + m * 16) * ldc + col0;
#pragma unroll
                for (int bj = 0; bj < 2; ++bj) { const f32x4 v0 = acc[ai][bj][m][0] * sc, v1 = acc[ai][bj][m][1] * sc;
                    u32x4 w; w.x = cvt_pk_bf16(v0[0], v0[1]); w.y = cvt_pk_bf16(v0[2], v0[3]); w.z = cvt_pk_bf16(v1[0], v1[1]); w.w = cvt_pk_bf16(v1[2], v1[3]);
                    *(u32x4*)(rowp + bj * HALF) = w; } }
    }
};
struct EpiPoolProj {
    static constexpr bool PERM = false, AFTER_DRAIN = false;
    float* T; const bf16_t* GP;
    __device__ __forceinline__ void operator()(const f32x4 (&acc)[2][2][4][2], const Unit& u, int wr, int wc, int fr, int fq) const {
        const int row0 = u.pm * BM + wr * 64 + fr, col0 = u.pn * BM + wc * 32 + 4 * fq;
#pragma unroll
        for (int ai = 0; ai < 2; ++ai)
#pragma unroll
            for (int m = 0; m < 4; ++m) { const size_t off = (size_t)(row0 + ai * HALF + m * 16) * 1024 + col0;
#pragma unroll
                for (int bj = 0; bj < 2; ++bj)
#pragma unroll
                    for (int n = 0; n < 2; ++n) { const size_t o2 = off + bj * HALF + n * 16; const u32x2 gw = *(const u32x2*)(GP + o2);
                        f32x4 g; g[0] = sigmoidf_fast(__uint_as_float(gw.x << 16)); g[1] = sigmoidf_fast(__uint_as_float(gw.x & 0xffff0000u));
                        g[2] = sigmoidf_fast(__uint_as_float(gw.y << 16)); g[3] = sigmoidf_fast(__uint_as_float(gw.y & 0xffff0000u));
                        *(f32x4*)(T + o2) = acc[ai][bj][m][n] * g; } }
    }
};
struct EpiAttnProj {
    static constexpr bool PERM = false, AFTER_DRAIN = false;
    const float* T; const bf16_t* GA; bf16_t* MG;
    __device__ __forceinline__ void operator()(const f32x4 (&acc)[2][2][4][2], const Unit& u, int wr, int wc, int fr, int fq) const {
        const int row0 = u.pm * BM + wr * 64 + fr, col0 = u.pn * BM + wc * 32 + 4 * fq;
#pragma unroll
        for (int ai = 0; ai < 2; ++ai)
#pragma unroll
            for (int m = 0; m < 4; ++m) { const size_t off = (size_t)(row0 + ai * HALF + m * 16) * 1024 + col0;
#pragma unroll
                for (int bj = 0; bj < 2; ++bj)
#pragma unroll
                    for (int n = 0; n < 2; ++n) { const size_t o2 = off + bj * HALF + n * 16; const u32x2 gw = *(const u32x2*)(GA + o2); const f32x4 t = *(const f32x4*)(T + o2);
                        f32x4 g; g[0] = sigmoidf_fast(__uint_as_float(gw.x << 16)); g[1] = sigmoidf_fast(__uint_as_float(gw.x & 0xffff0000u));
                        g[2] = sigmoidf_fast(__uint_as_float(gw.y << 16)); g[3] = sigmoidf_fast(__uint_as_float(gw.y & 0xffff0000u));
                        const f32x4 v = t + acc[ai][bj][m][n] * g;
                        u32x2 w; w.x = cvt_pk_bf16(v[0], v[1]); w.y = cvt_pk_bf16(v[2], v[3]);
                        *(u32x2*)(MG + o2) = w; } }
    }
};
template <class Epi, class Sched, bool ALIGN_EPI = false, bool SP2 = false>
__device__ __forceinline__ void gemm_phase(PG8_LAS unsigned char* lds, const Gemm g, const Sched& S, const Epi& E) {
    int tid_ = threadIdx.x; asm volatile("" : "+v"(tid_)); const int tid = tid_, wid = __builtin_amdgcn_readfirstlane(tid >> 6), lane = tid & 63, wr = wid >> 2, wc = wid & 3, fr = lane & 15, fq = lane >> 4;
    const int K = g.K, nt = K / BK;
    unsigned voffA[2], voffB[2];
#pragma unroll
    for (int i = 0; i < 2; ++i) { int R, C; stage_rc(tid * 16 + i * 8192, R, C); const int Rb = Epi::PERM ? ((R & ~31) + perm32(R & 31)) : R;
        voffA[i] = (unsigned)(R * K + C) * 2u; voffB[i] = (unsigned)(Rb * K + C) * 2u; }
    const size_t kstep = (size_t)(BK * 2);
    const size_t hstep = (size_t)HALF * K * 2;
    const size_t tstep = 2 * hstep;
    const unsigned ldsw = (unsigned)wid * 1024u;
    const int aoff = lds_byte(wr * 64 + fr, fq * 8), boff = lds_byte(wc * 32 + fr, fq * 8);
#define PG8_SA(b, h) (((b) * 2 + (h)) * HTB)
#define PG8_SB(b, h) ((4 + (b) * 2 + (h)) * HTB)
#define PG8_STAGE(bufoff, gbase, voff) do { _Pragma("unroll") for (int _i = 0; _i < 2; ++_i) \
        __builtin_amdgcn_global_load_lds((const unsigned*)((const char*)(gbase) + (voff)[_i]), (PG8_LAS unsigned*)(lds + (bufoff) + ldsw + _i * 8192), 16, 0, 0); } while (0)
#define PG8_LDA(dst, b, h) do { _Pragma("unroll") for (int m = 0; m < 4; ++m) _Pragma("unroll") for (int k = 0; k < 2; ++k) dst[m][k] = *(const PG8_LAS bf16x8*)(lds + PG8_SA(b, h) + aoff + m * 2048 + k * 1024); } while (0)
#define PG8_LDB(dst, b, h) do { _Pragma("unroll") for (int n = 0; n < 2; ++n) _Pragma("unroll") for (int k = 0; k < 2; ++k) dst[n][k] = *(const PG8_LAS bf16x8*)(lds + PG8_SB(b, h) + boff + n * 2048 + k * 1024); } while (0)
#define PG8_MMA(ai, bj, At, Bt) do { __builtin_amdgcn_s_setprio(1); _Pragma("unroll") for (int m = 0; m < 4; ++m) _Pragma("unroll") for (int n = 0; n < 2; ++n) _Pragma("unroll") for (int k = 0; k < 2; ++k) \
        acc[ai][bj][m][n] = __builtin_amdgcn_mfma_f32_16x16x32_bf16(Bt[n][k], At[m][k], acc[ai][bj][m][n], 0, 0, 0); __builtin_amdgcn_s_setprio(0); } while (0)
#define PG8_WAIT_V(n) asm volatile("s_waitcnt vmcnt(" #n ")" ::: "memory")
#define PG8_WAIT_L(n) asm volatile("s_waitcnt lgkmcnt(" #n ")" ::: "memory")
#define PG8_BAR __builtin_amdgcn_s_barrier()
#define PG8_SCHED __builtin_amdgcn_sched_barrier(0)
    Unit cur, nxt; int ui = 0;
    if (!S.next(0, cur)) return;
    f32x4 acc[2][2][4][2];
#pragma unroll
    for (int a = 0; a < 2; ++a)
#pragma unroll
        for (int b = 0; b < 2; ++b)
#pragma unroll
            for (int m = 0; m < 4; ++m)
#pragma unroll
                for (int n = 0; n < 2; ++n) acc[a][b][m][n] = (f32x4){0.f, 0.f, 0.f, 0.f};
    bf16x8 At[4][2], B0[2][2], B1[2][2];
    const char* cA = (const char*)g.A + (size_t)cur.pm * tstep; const char* cB = (const char*)g.Bt + (size_t)cur.pn * tstep;
    S.a_ready(cur);
    if constexpr (SP2) {
        PG8_STAGE(PG8_SB(0, 0), cB, voffB); PG8_STAGE(PG8_SB(0, 1), cB + hstep, voffB); PG8_STAGE(PG8_SA(0, 0), cA, voffA); PG8_STAGE(PG8_SA(0, 1), cA + hstep, voffA);
        if (wr == 1) PG8_BAR;
        PG8_WAIT_V(2); PG8_BAR;
        PG8_STAGE(PG8_SB(1, 0), cB + kstep, voffB); PG8_STAGE(PG8_SA(1, 0), cA + kstep, voffA); PG8_STAGE(PG8_SB(1, 1), cB + hstep + kstep, voffB);
        PG8_WAIT_V(6); PG8_BAR;
    } else {
        PG8_STAGE(PG8_SB(0, 0), cB, voffB); PG8_STAGE(PG8_SA(0, 0), cA, voffA); PG8_STAGE(PG8_SB(0, 1), cB + hstep, voffB); PG8_STAGE(PG8_SA(0, 1), cA + hstep, voffA);
        if (wr == 1) PG8_BAR;
        PG8_WAIT_V(4); PG8_BAR;
        PG8_STAGE(PG8_SB(1, 0), cB + kstep, voffB); PG8_STAGE(PG8_SA(1, 0), cA + kstep, voffA); PG8_STAGE(PG8_SB(1, 1), cB + hstep + kstep, voffB);
        PG8_WAIT_V(6); PG8_BAR;
    }
    for (;;) {
        const bool has_next = S.next(ui + 1, nxt);
        const char* nA = has_next ? (const char*)g.A + (size_t)nxt.pm * tstep : cA; const char* nB = has_next ? (const char*)g.Bt + (size_t)nxt.pn * tstep : cB;
        for (int t = 0; t < nt; t += 2) {
            const bool last = (t == nt - 2);
            const char* a1 = cA + (size_t)(t + 1) * kstep;
            const char* a2 = last ? nA : cA + (size_t)(t + 2) * kstep; const char* b2 = last ? nB : cB + (size_t)(t + 2) * kstep;
            const char* a3 = a2 + kstep; const char* b3 = b2 + kstep;
            if (last && has_next) S.a_ready(nxt);
            if constexpr (SP2) {
            PG8_LDB(B0, 0, 0); PG8_LDB(B1, 0, 1); PG8_SCHED; PG8_LDA(At, 0, 0); PG8_STAGE(PG8_SA(1, 1), a1 + hstep, voffA);
            PG8_WAIT_V(8); PG8_WAIT_L(0); PG8_BAR; PG8_MMA(0, 0, At, B0); PG8_MMA(0, 1, At, B1); PG8_BAR; PG8_SCHED;
            PG8_LDA(At, 0, 1); PG8_STAGE(PG8_SB(0, 0), b2, voffB); PG8_STAGE(PG8_SB(0, 1), b2 + hstep, voffB); PG8_STAGE(PG8_SA(0, 0), a2, voffA);
            PG8_WAIT_V(8); PG8_WAIT_L(0); PG8_BAR; PG8_MMA(1, 0, At, B0); PG8_MMA(1, 1, At, B1); PG8_BAR; PG8_SCHED;
            PG8_LDB(B0, 1, 0); PG8_LDB(B1, 1, 1); PG8_SCHED; PG8_LDA(At, 1, 0); PG8_STAGE(PG8_SA(0, 1), a2 + hstep, voffA);
            PG8_WAIT_V(8); PG8_WAIT_L(0); PG8_BAR; PG8_MMA(0, 0, At, B0); PG8_MMA(0, 1, At, B1); PG8_BAR; PG8_SCHED;
            PG8_LDA(At, 1, 1); PG8_STAGE(PG8_SB(1, 0), b3, voffB); PG8_STAGE(PG8_SB(1, 1), b3 + hstep, voffB); PG8_STAGE(PG8_SA(1, 0), a3, voffA);
            PG8_WAIT_V(8); PG8_WAIT_L(0); PG8_BAR; PG8_MMA(1, 0, At, B0); PG8_MMA(1, 1, At, B1); PG8_BAR; PG8_SCHED;
            } else {
            PG8_LDB(B0, 0, 0); PG8_SCHED; PG8_LDA(At, 0, 0); PG8_STAGE(PG8_SA(1, 1), a1 + hstep, voffA);
            PG8_WAIT_L(8); PG8_BAR; PG8_WAIT_L(0); PG8_MMA(0, 0, At, B0); PG8_BAR; PG8_SCHED;
            PG8_LDB(B1, 0, 1); PG8_STAGE(PG8_SB(0, 0), b2, voffB);
            PG8_BAR; PG8_WAIT_L(0); PG8_MMA(0, 1, At, B1); PG8_BAR;
            PG8_LDA(At, 0, 1); PG8_STAGE(PG8_SA(0, 0), a2, voffA);
            PG8_BAR; PG8_WAIT_L(0); PG8_MMA(1, 0, At, B0); PG8_BAR; PG8_SCHED;
            PG8_STAGE(PG8_SB(0, 1), b2 + hstep, voffB);
            PG8_WAIT_V(6); PG8_BAR; PG8_MMA(1, 1, At, B1); PG8_BAR;
            PG8_LDB(B0, 1, 0); PG8_SCHED; PG8_LDA(At, 1, 0); PG8_STAGE(PG8_SA(0, 1), a2 + hstep, voffA);
            PG8_WAIT_L(8); PG8_BAR; PG8_WAIT_L(0); PG8_MMA(0, 0, At, B0); PG8_BAR; PG8_SCHED;
            PG8_LDB(B1, 1, 1); PG8_STAGE(PG8_SB(1, 0), b3, voffB);
            PG8_BAR; PG8_WAIT_L(0); PG8_MMA(0, 1, At, B1); PG8_BAR;
            PG8_LDA(At, 1, 1); PG8_STAGE(PG8_SA(1, 0), a3, voffA);
            PG8_BAR; PG8_WAIT_L(0); PG8_MMA(1, 0, At, B0); PG8_BAR; PG8_SCHED;
            PG8_STAGE(PG8_SB(1, 1), b3 + hstep, voffB);
            PG8_WAIT_V(6); PG8_BAR; PG8_MMA(1, 1, At, B1); PG8_BAR;
            }
        }
        if constexpr (ALIGN_EPI) { if (wr == 0) PG8_BAR; }
        if constexpr (!Epi::AFTER_DRAIN) { E(acc, cur, wr, wc, fr, fq); S.done(cur); }
        if (!has_next) break;
#pragma unroll
        for (int a = 0; a < 2; ++a)
#pragma unroll
            for (int b = 0; b < 2; ++b)
#pragma unroll
                for (int m = 0; m < 4; ++m)
#pragma unroll
                    for (int n = 0; n < 2; ++n) acc[a][b][m][n] = (f32x4){0.f, 0.f, 0.f, 0.f};
        cur = nxt; cA = nA; cB = nB; ++ui;
        if constexpr (ALIGN_EPI) { if (wr == 1) PG8_BAR; }
    }
    PG8_WAIT_V(0);
    if constexpr (!ALIGN_EPI) { if (wr == 0) PG8_BAR; }
    PG8_BAR;
    if constexpr (Epi::AFTER_DRAIN) { E.fused(acc, cur, wr, wc, fr, fq, lds, wid, lane); S.done(cur); }
#undef PG8_SA
#undef PG8_SB
#undef PG8_STAGE
#undef PG8_LDA
#undef PG8_LDB
#undef PG8_MMA
#undef PG8_WAIT_V
#undef PG8_WAIT_L
#undef PG8_BAR
#undef PG8_SCHED
}
}

#define LAS __attribute__((address_space(3)))
typedef unsigned short bf16;
typedef unsigned v4u __attribute__((ext_vector_type(4)));
typedef unsigned v2u __attribute__((ext_vector_type(2)));
typedef float f32x4 __attribute__((ext_vector_type(4)));
typedef float f32x16 __attribute__((ext_vector_type(16)));
typedef short bf16x8 __attribute__((ext_vector_type(8)));
constexpr int NTOK = 16384, NMETA = 16, LTOT = NTOK + NMETA, MP = 16640, D = 1024, DFF = 2816, NIN = 4096;
constexpr float RMS_EPS = 1e-6f, LOG2E = 1.4426950408889634f;
constexpr int NWAVES = 8, NTHR = 512;
constexpr size_t MiB = 1u << 20;
constexpr size_t WS_HMETA = 512 * 1024;
constexpr size_t WS_WFI = 1 * MiB, SZ_WFI1 = (size_t)2 * DFF * D * 2;
constexpr size_t WS_WFO = WS_WFI + 4 * SZ_WFI1, SZ_WFO1 = (size_t)D * DFF * 2;
constexpr size_t WS_WIN = WS_WFO + 4 * SZ_WFO1, SZ_WIN1 = (size_t)NIN * D * 2;
constexpr size_t WS_WC = WS_WIN + 2 * SZ_WIN1, SZ_WC1 = (size_t)D * 512 * 2;
constexpr size_t WS_WAT = WS_WC + 2 * SZ_WC1, SZ_SQ = (size_t)D * D * 2;
constexpr size_t WS_WO = WS_WAT + 2 * SZ_SQ;
constexpr size_t SZ_ROWS_BF = (size_t)MP * D * 2;
constexpr size_t WS_XN = WS_WO + 2 * SZ_SQ;
constexpr size_t WS_Y = WS_XN + SZ_ROWS_BF;
constexpr size_t WS_ARENA = WS_Y + (size_t)MP * D * 4;
constexpr size_t WS_G = WS_ARENA;
constexpr size_t WS_U = WS_ARENA, WS_Q = WS_U + (size_t)MP * 512 * 2, WS_K = WS_Q + SZ_ROWS_BF, WS_V = WS_K + (size_t)MP * 256 * 2,
                 WS_GP = WS_V + (size_t)MP * 256 * 2, WS_GA = WS_GP + SZ_ROWS_BF, WS_PM = WS_GA + SZ_ROWS_BF, WS_END = WS_PM + (size_t)MP * 512 * 2;
static_assert(WS_G + (size_t)MP * DFF * 2 <= WS_END, "arena");
constexpr int LDS_BYTES = 131072 + 4096;

__device__ __forceinline__ float wave_sum(float v) {
#pragma unroll
    for (int o = 1; o < 64; o <<= 1) v += __shfl_xor(v, o);
    return v;
}
__device__ __forceinline__ unsigned pk2(float lo, float hi) { return pg8::cvt_pk_bf16(lo, hi); }
__device__ __forceinline__ float bflo(unsigned w) { return __uint_as_float(w << 16); }
__device__ __forceinline__ float bfhi(unsigned w) { return __uint_as_float(w & 0xffff0000u); }

__device__ __forceinline__ void transpose_item(const float* W, int K, int N, bf16* WT, int dst_row0, int k0, int n0, LAS float* scr, int lane) {
#pragma unroll 8
    for (int i = 0; i < 32; ++i) { const int kk = 2 * i + (lane >> 5); scr[kk * 33 + (lane & 31)] = W[(size_t)(k0 + kk) * N + n0 + (lane & 31)]; }
    asm volatile("s_waitcnt lgkmcnt(0)" ::: "memory");
    const int c = lane & 7;
#pragma unroll
    for (int j = 0; j < 4; ++j) { const int n = (lane >> 3) + 8 * j; const LAS float* s = scr + (8 * c) * 33 + n;
        v4u o; o.x = pk2(s[0 * 33], s[1 * 33]); o.y = pk2(s[2 * 33], s[3 * 33]); o.z = pk2(s[4 * 33], s[5 * 33]); o.w = pk2(s[6 * 33], s[7 * 33]);
        *(v4u*)(WT + (size_t)(dst_row0 + n) * K + k0 + 8 * c) = o; }
    asm volatile("s_waitcnt lgkmcnt(0)" ::: "memory");
}

struct Args { const float* in[12]; float* out; unsigned char* ws; int ph_lo, ph_hi; };

__device__ __forceinline__ void prologue(const Args& a, LAS unsigned char* lds, int wave, int lane, int tid) {
    unsigned char* ws = a.ws;
    LAS float* scr = (LAS float*)(lds + wave * 16384);
    const int G = gridDim.x, gw = blockIdx.x * NWAVES + wave, NGW = G * NWAVES;
    constexpr int I_FI = 16 * 176, I_FO = 44 * 32, I_WIN = 16 * 128, I_SQ = 16 * 32;
    constexpr int NITEMS = 4 * I_FI + 4 * I_FO + 2 * I_WIN + 4 * I_SQ;
    for (int it = gw; it < NITEMS; it += NGW) {
        int r = it;
        if (r < 4 * I_FI) { const int mi = r / I_FI; r -= mi * I_FI; const int kb = r / 176, nb = r % 176, n0 = nb * 32;
            const int j0 = n0 < DFF ? n0 : n0 - DFF; const int dst = (j0 >> 7) * 256 + (n0 < DFF ? 0 : 128) + (j0 & 127);
            transpose_item(a.in[3] + (size_t)mi * D * 2 * DFF, D, 2 * DFF, (bf16*)(ws + WS_WFI + mi * SZ_WFI1), dst, kb * 64, n0, scr, lane); continue; }
        r -= 4 * I_FI;
        if (r < 4 * I_FO) { const int mi = r / I_FO; r -= mi * I_FO; const int kb = r / 32, nb = r % 32;
            transpose_item(a.in[4] + (size_t)mi * DFF * D, DFF, D, (bf16*)(ws + WS_WFO + mi * SZ_WFO1), nb * 32, kb * 64, nb * 32, scr, lane); continue; }
        r -= 4 * I_FO;
        if (r < 2 * I_WIN) { const int mi = r / I_WIN; r -= mi * I_WIN; const int kb = r / 128, nb = r % 128;
            transpose_item(a.in[5] + (size_t)mi * D * NIN, D, NIN, (bf16*)(ws + WS_WIN + mi * SZ_WIN1), nb * 32, kb * 64, nb * 32, scr, lane); continue; }
        r -= 2 * I_WIN;
        { const int mi = r / I_SQ; r -= mi * I_SQ; const int kb = r / 32, nb = r % 32;
            const float* W = (mi < 2) ? a.in[10] + (size_t)mi * D * D : a.in[11] + (size_t)(mi - 2) * D * D;
            bf16* WT = (mi < 2) ? (bf16*)(ws + WS_WAT + mi * SZ_SQ) : (bf16*)(ws + WS_WO + (mi - 2) * SZ_SQ);
            transpose_item(W, D, D, WT, nb * 32, kb * 64, nb * 32, scr, lane); }
    }
    {
        const int gt = blockIdx.x * NTHR + tid, NT = G * NTHR;
        for (int it = gt; it < 2 * 64 * 1024; it += NT) {
            const int n = it & 1023, k8 = (it >> 10) & 63, l = it >> 16, g = k8 >> 4, c0 = (k8 & 15) * 8;
            const float* wg = a.in[6] + ((size_t)(l * 4 + g) * 128 + c0) * 128;
            const float* sc = a.in[7] + l * 512 + g * 128;
            const float* wp = a.in[8] + ((size_t)l * 512 + g * 128) * D + n;
            float acc[8];
#pragma unroll
            for (int i = 0; i < 8; ++i) acc[i] = 0.f;
            for (int d = 0; d < 128; ++d) { const float t = sc[d] * wp[(size_t)d * D];
#pragma unroll
                for (int i = 0; i < 8; ++i) acc[i] += wg[i * 128 + d] * t; }
            v4u o; o.x = pk2(acc[0], acc[1]); o.y = pk2(acc[2], acc[3]); o.z = pk2(acc[4], acc[5]); o.w = pk2(acc[6], acc[7]);
            *(v4u*)((bf16*)(ws + WS_WC + l * SZ_WC1) + (size_t)n * 512 + k8 * 8) = o;
        }
    }
    {
        const float* g = a.in[2];
        f32x4 gv[4];
#pragma unroll
        for (int j = 0; j < 4; ++j) gv[j] = *((const f32x4*)g + lane + 64 * j);
        for (int r = gw; r < LTOT; r += NGW) {
            const float* src = r < NTOK ? a.in[0] + (size_t)r * D : a.in[1] + (size_t)(r - NTOK) * D;
            float* dst = r < NTOK ? a.out + (size_t)r * D : (float*)(ws + WS_HMETA) + (size_t)(r - NTOK) * D;
            f32x4 v[4]; float ss = 0.f;
#pragma unroll
            for (int j = 0; j < 4; ++j) { v[j] = *((const f32x4*)src + lane + 64 * j); ss += (v[j].x * v[j].x + v[j].y * v[j].y) + (v[j].z * v[j].z + v[j].w * v[j].w); }
            const float rs = __builtin_amdgcn_rsqf(wave_sum(ss) * (1.f / D) + RMS_EPS);
            bf16* xn = (bf16*)(ws + WS_XN) + (size_t)r * D;
#pragma unroll
            for (int j = 0; j < 4; ++j) { *((f32x4*)dst + lane + 64 * j) = v[j]; const f32x4 o = v[j] * rs * gv[j];
                v2u w; w.x = pk2(o.x, o.y); w.y = pk2(o.z, o.w); *((v2u*)xn + lane + 64 * j) = w; }
        }
    }
}

__device__ __forceinline__ void rownorm_phase(const Args& a, const float* gpost, const float* gpre, float coef, bool last, int wave, int lane) {
    unsigned char* ws = a.ws;
    const int gw = blockIdx.x * NWAVES + wave, NGW = gridDim.x * NWAVES;
    f32x4 gp[4], gq[4];
#pragma unroll
    for (int j = 0; j < 4; ++j) { gp[j] = *((const f32x4*)gpost + lane + 64 * j) * coef; gq[j] = gpre ? *((const f32x4*)gpre + lane + 64 * j) : (f32x4){0.f, 0.f, 0.f, 0.f}; }
    const int nrows = last ? NTOK : LTOT;
    for (int r = gw; r < nrows; r += NGW) {
        float* h = r < NTOK ? a.out + (size_t)r * D : (float*)(ws + WS_HMETA) + (size_t)(r - NTOK) * D;
        const float* y = (const float*)(ws + WS_Y) + (size_t)r * D;
        f32x4 yv[4], hv[4]; float ss = 0.f;
#pragma unroll
        for (int j = 0; j < 4; ++j) { yv[j] = *((const f32x4*)y + lane + 64 * j); hv[j] = *((const f32x4*)h + lane + 64 * j); ss += (yv[j].x * yv[j].x + yv[j].y * yv[j].y) + (yv[j].z * yv[j].z + yv[j].w * yv[j].w); }
        const float rs = __builtin_amdgcn_rsqf(wave_sum(ss) * (1.f / D) + RMS_EPS);
        float s2 = 0.f;
#pragma unroll
        for (int j = 0; j < 4; ++j) { hv[j] = hv[j] + yv[j] * rs * gp[j]; *((f32x4*)h + lane + 64 * j) = hv[j]; s2 += (hv[j].x * hv[j].x + hv[j].y * hv[j].y) + (hv[j].z * hv[j].z + hv[j].w * hv[j].w); }
        if (gpre) {
            const float r2 = __builtin_amdgcn_rsqf(wave_sum(s2) * (1.f / D) + RMS_EPS);
            bf16* xn = (bf16*)(ws + WS_XN) + (size_t)r * D;
#pragma unroll
            for (int j = 0; j < 4; ++j) { const f32x4 o = hv[j] * r2 * gq[j]; v2u w; w.x = pk2(o.x, o.y); w.y = pk2(o.z, o.w); *((v2u*)xn + lane + 64 * j) = w; }
        }
    }
}

constexpr int KS_PITCH = 144, VT_PITCH = 584, ATT_VT_OFF = 288 * KS_PITCH;
__device__ __forceinline__ int crow(int r, int hi) { return (r & 3) + 8 * (r >> 2) + 4 * hi; }

template <bool META>
__device__ __forceinline__ f32x16 attn_scores(LAS unsigned char* lds, const bf16x8 (&qf)[4], int tt, int sb, bool b0, float slope2, int i, int hi) {
    const float NEG = -1e30f;
    const int t = (tt < 5) ? sb + tt : 8;
    const LAS unsigned char* kb = lds + (32 * t + i) * KS_PITCH + hi * 16;
    f32x16 c = {};
#pragma unroll
    for (int d0 = 0; d0 < 4; ++d0) { const bf16x8 kf = *(const LAS bf16x8*)(kb + d0 * 32); c = __builtin_amdgcn_mfma_f32_32x32x16_bf16(kf, qf[d0], c, 0, 0, 0); }
    if (tt < 5) {
        const bool tile_ok = !(b0 && t < 4);
#pragma unroll
        for (int r = 0; r < 16; ++r) { const int dist = 128 - 32 * tt + i - crow(r, hi); const bool ok = tile_ok && dist >= 0 && dist <= 127; c[r] = ok ? c[r] - slope2 * (float)dist : NEG; }
    } else {
#pragma unroll
        for (int r = 0; r < 16; ++r) { const int cr = crow(r, hi); const bool ok = (cr < 16) && (!META || cr <= i); c[r] = ok ? c[r] : NEG; }
    }
    return c;
}
template <bool META>
__device__ __forceinline__ void attn_task(LAS unsigned char* lds, const bf16* Q, bf16* O, int qrow0, int h, int sb, bool b0, float slope2, float sink2, int lane) {
    const int i = lane & 31, hi = lane >> 5;
    const bf16* qp = Q + (size_t)(qrow0 + i) * D + h * 64 + hi * 8;
    bf16x8 qf[4];
#pragma unroll
    for (int d0 = 0; d0 < 4; ++d0) qf[d0] = *(const bf16x8*)(qp + d0 * 16);
    float m = sink2;
#pragma unroll 1
    for (int tt = META ? 5 : 0; tt < 6; ++tt) {
        const f32x16 c = attn_scores<META>(lds, qf, tt, sb, b0, slope2, i, hi);
#pragma unroll
        for (int r = 0; r < 16; ++r) m = fmaxf(m, c[r]);
    }
    m = fmaxf(m, __shfl_xor(m, 32));
    float s = 0.f;
    f32x16 o[2]; o[0] = f32x16{}; o[1] = f32x16{};
#pragma unroll 1
    for (int tt = META ? 5 : 0; tt < 6; ++tt) {
        f32x16 p = attn_scores<META>(lds, qf, tt, sb, b0, slope2, i, hi);
#pragma unroll
        for (int r = 0; r < 16; ++r) { p[r] = __builtin_amdgcn_exp2f(p[r] - m); s += p[r]; }
        const int t = (tt < 5) ? sb + tt : 8;
#pragma unroll
        for (int kb = 0; kb < 2; ++kb) {
            if (tt == 5 && kb == 1) break;
            v4u pw; pw.x = pk2(p[8 * kb + 0], p[8 * kb + 1]); pw.y = pk2(p[8 * kb + 2], p[8 * kb + 3]); pw.z = pk2(p[8 * kb + 4], p[8 * kb + 5]); pw.w = pk2(p[8 * kb + 6], p[8 * kb + 7]);
            const bf16x8 pb = __builtin_bit_cast(bf16x8, pw);
#pragma unroll
            for (int dh = 0; dh < 2; ++dh) {
                const LAS unsigned char* vp = lds + ATT_VT_OFF + (32 * dh + i) * VT_PITCH + (32 * t + 16 * kb + 4 * hi) * 2;
                const v2u lo = *(const LAS v2u*)vp, hi8 = *(const LAS v2u*)(vp + 16);
                v4u av; av.x = lo.x; av.y = lo.y; av.z = hi8.x; av.w = hi8.y;
                o[dh] = __builtin_amdgcn_mfma_f32_32x32x16_bf16(__builtin_bit_cast(bf16x8, av), pb, o[dh], 0, 0, 0);
            }
        }
    }
    s += __shfl_xor(s, 32);
    s += __builtin_amdgcn_exp2f(sink2 - m);
    const float inv = 1.0f / s;
    if (META && i >= 16) return;
    bf16* op = O + (size_t)(qrow0 + i) * D + h * 64 + 4 * hi;
#pragma unroll
    for (int dh = 0; dh < 2; ++dh)
#pragma unroll
        for (int r4 = 0; r4 < 4; ++r4) { v2u w; w.x = pk2(o[dh][4 * r4 + 0] * inv, o[dh][4 * r4 + 1] * inv); w.y = pk2(o[dh][4 * r4 + 2] * inv, o[dh][4 * r4 + 3] * inv);
            *(v2u*)(op + 32 * dh + 8 * r4) = w; }
}

__device__ __forceinline__ void attn_load(LAS unsigned char* lds, const bf16* Kb, const bf16* Vb, int blk, int kvh, int tid) {
    const bool meta = blk == 128;
    const v4u z = {0u, 0u, 0u, 0u};
    for (int item = tid + (meta ? 2048 : 0); item < 288 * 8; item += NTHR) {
        const int s = item >> 3, ch = item & 7;
        int row = -1;
        if (s < 256) { row = 128 * (blk - 1) + s; } else if (s < 272) row = NTOK + (s - 256);
        v4u v = z;
        if (row >= 0) v = *(const v4u*)(Kb + (size_t)row * 256 + kvh * 64 + ch * 8);
        *(LAS v4u*)(lds + s * KS_PITCH + ch * 16) = v;
    }
    for (int item = tid + (meta ? 1024 : 0); item < 144 * 8; item += NTHR) {
        const int kp = item >> 3, ch = item & 7, s = 2 * kp;
        int row = -1;
        if (s < 256) { row = 128 * (blk - 1) + s; } else if (s < 272) row = NTOK + (s - 256);
        v4u v0 = z, v1 = z;
        if (row >= 0) { v0 = *(const v4u*)(Vb + (size_t)row * 256 + kvh * 64 + ch * 8); v1 = *(const v4u*)(Vb + (size_t)(row + 1) * 256 + kvh * 64 + ch * 8); }
        LAS unsigned char* vt = lds + ATT_VT_OFF + (ch * 8) * VT_PITCH + kp * 4;
        *(LAS unsigned*)(vt + 0 * VT_PITCH) = (v0.x & 0xffffu) | (v1.x << 16);
        *(LAS unsigned*)(vt + 1 * VT_PITCH) = (v0.x >> 16) | (v1.x & 0xffff0000u);
        *(LAS unsigned*)(vt + 2 * VT_PITCH) = (v0.y & 0xffffu) | (v1.y << 16);
        *(LAS unsigned*)(vt + 3 * VT_PITCH) = (v0.y >> 16) | (v1.y & 0xffff0000u);
        *(LAS unsigned*)(vt + 4 * VT_PITCH) = (v0.z & 0xffffu) | (v1.z << 16);
        *(LAS unsigned*)(vt + 5 * VT_PITCH) = (v0.z >> 16) | (v1.z & 0xffff0000u);
        *(LAS unsigned*)(vt + 6 * VT_PITCH) = (v0.w & 0xffffu) | (v1.w << 16);
        *(LAS unsigned*)(vt + 7 * VT_PITCH) = (v0.w >> 16) | (v1.w & 0xffff0000u);
    }
}

__device__ __forceinline__ void mix_phase(const Args& a, int l, LAS unsigned char* lds, int wave, int lane, int tid) {
    unsigned char* ws = a.ws;
    const bf16* Kb = (const bf16*)(ws + WS_K); const bf16* Vb = (const bf16*)(ws + WS_V);
    bf16* Qb = (bf16*)(ws + WS_Q);
    const int G = gridDim.x;
    const float* sinks = a.in[9] + l * 16;
    for (int u = blockIdx.x; u < 512; u += G) {
        const int blk = u >> 2, kvh = u & 3;
        attn_load(lds, Kb, Vb, blk, kvh, tid);
        __syncthreads();
#pragma unroll 1
        for (int j = 0; j < 2; ++j) {
            const int task = wave * 2 + j, g = task >> 2, sb = task & 3, h = kvh * 4 + g;
            const float slope2 = exp2f(-0.5f * (float)(h + 1)) * LOG2E, sink2 = sinks[h] * LOG2E;
            attn_task<false>(lds, Qb, Qb, 128 * blk + 32 * sb, h, sb, blk == 0, slope2, sink2, lane);
        }
        __syncthreads();
    }
    if (blockIdx.x < 4) {
        const int kvh = blockIdx.x;
        attn_load(lds, Kb, Vb, 128, kvh, tid);
        __syncthreads();
        if (wave < 4) { const int h = kvh * 4 + wave; attn_task<true>(lds, Qb, Qb, NTOK, h, 0, false, 0.f, sinks[h] * LOG2E, lane); }
        __syncthreads();
    }
    {
        const bf16* U = (const bf16*)(ws + WS_U); bf16* PM = (bf16*)(ws + WS_PM);
        const int gt = blockIdx.x * NTHR + tid, NT = G * NTHR;
        for (int item = gt; item < LTOT * 64; item += NT) {
            const int pos = item >> 6, c8 = item & 63, w = 2 << (c8 >> 4), cnt = (pos + 1 < w) ? pos + 1 : w;
            float acc[8], self[8];
#pragma unroll
            for (int e = 0; e < 8; ++e) acc[e] = 0.f;
            for (int k = 0; k < cnt; ++k) { const int pp = pos - k, rr = pp < NMETA ? NTOK + pp : pp - NMETA;
                const v4u v = *(const v4u*)(U + (size_t)rr * 512 + c8 * 8);
                const float f[8] = {bflo(v.x), bfhi(v.x), bflo(v.y), bfhi(v.y), bflo(v.z), bfhi(v.z), bflo(v.w), bfhi(v.w)};
#pragma unroll
                for (int e = 0; e < 8; ++e) { acc[e] += f[e]; if (k == 0) self[e] = f[e]; } }
            const float ic = 1.0f / (float)cnt;
            const int row = pos < NMETA ? NTOK + pos : pos - NMETA;
            v4u o; o.x = pk2(acc[0] * ic - self[0], acc[1] * ic - self[1]); o.y = pk2(acc[2] * ic - self[2], acc[3] * ic - self[3]);
            o.z = pk2(acc[4] * ic - self[4], acc[5] * ic - self[5]); o.w = pk2(acc[6] * ic - self[6], acc[7] * ic - self[7]);
            *(v4u*)(PM + (size_t)row * 512 + c8 * 8) = o;
        }
    }
}

constexpr int NPHASES = 23;
__global__ void __launch_bounds__(NTHR, 2) fwd_kernel(Args a) {
    extern __shared__ __attribute__((aligned(16))) unsigned char lds_raw[];
    LAS unsigned char* lds = (LAS unsigned char*)lds_raw;
    cg::grid_group grid = cg::this_grid();
    unsigned char* ws = a.ws;
    const int G = gridDim.x, c = blockIdx.x;
    bf16* XN = (bf16*)(ws + WS_XN); float* Y = (float*)(ws + WS_Y);
#pragma unroll 1
    for (int ph = a.ph_lo; ph < a.ph_hi; ++ph) {
        int t_ = threadIdx.x; asm volatile("" : "+v"(t_)); const int tid = t_, lane = tid & 63, wave = __builtin_amdgcn_readfirstlane(tid >> 6);
        if (ph == 0) prologue(a, lds, wave, lane, tid);
        else {
            const int l = (ph - 1) / 11, k = (ph - 1) % 11;
            const float* ng = a.in[2] + (size_t)l * 6 * D;
            if (k == 0 || k == 8) {
                const int mi = l * 2 + (k == 8);
                pg8::Gemm g{XN, (const bf16*)(ws + WS_WFI + mi * SZ_WFI1), MP, 2 * DFF, D}; pg8::StaticOrder S; S.init(MP, 2 * DFF, G, c);
                pg8::EpiSwiglu E{(bf16*)(ws + WS_G), DFF};
                pg8::gemm_phase<pg8::EpiSwiglu, pg8::StaticOrder, true, true>(lds, g, S, E);
            } else if (k == 1 || k == 9) {
                const int mi = l * 2 + (k == 9);
                pg8::Gemm g{(const bf16*)(ws + WS_G), (const bf16*)(ws + WS_WFO + mi * SZ_WFO1), MP, D, DFF}; pg8::StaticOrder S; S.init(MP, D, G, c);
                pg8::EpiF32 E{Y, D};
                pg8::gemm_phase<pg8::EpiF32, pg8::StaticOrder, true, true>(lds, g, S, E);
            } else if (k == 2) rownorm_phase(a, ng + 1 * D, ng + 2 * D, 0.5f, false, wave, lane);
            else if (k == 7) rownorm_phase(a, ng + 3 * D, ng + 4 * D, 1.0f, false, wave, lane);
            else if (k == 10) rownorm_phase(a, ng + 5 * D, l == 0 ? ng + 6 * D : nullptr, 0.5f, l == 1, wave, lane);
            else if (k == 3) {
                pg8::Gemm g{XN, (const bf16*)(ws + WS_WIN + l * SZ_WIN1), MP, NIN, D}; pg8::StaticOrder S; S.init(MP, NIN, G, c);
                pg8::EpiWin E{(bf16*)(ws + WS_U), (bf16*)(ws + WS_Q), (bf16*)(ws + WS_K), (bf16*)(ws + WS_V), (bf16*)(ws + WS_GP), (bf16*)(ws + WS_GA), 0.125f * LOG2E};
                pg8::gemm_phase<pg8::EpiWin, pg8::StaticOrder, true, true>(lds, g, S, E);
            } else if (k == 4) mix_phase(a, l, lds, wave, lane, tid);
            else if (k == 5) {
                { pg8::Gemm g{(const bf16*)(ws + WS_PM), (const bf16*)(ws + WS_WC + l * SZ_WC1), MP, D, 512}; pg8::StaticOrder S; S.init(MP, D, G, c);
                  pg8::EpiPoolProj E{Y, (const bf16*)(ws + WS_GP)};
                  pg8::gemm_phase<pg8::EpiPoolProj, pg8::StaticOrder, true, true>(lds, g, S, E); }
                { pg8::Gemm g{(const bf16*)(ws + WS_Q), (const bf16*)(ws + WS_WAT + l * SZ_SQ), MP, D, D}; pg8::StaticOrder S; S.init(MP, D, G, c);
                  pg8::EpiAttnProj E{Y, (const bf16*)(ws + WS_GA), XN};
                  pg8::gemm_phase<pg8::EpiAttnProj, pg8::StaticOrder, true, true>(lds, g, S, E); }
            } else if (k == 6) {
                pg8::Gemm g{XN, (const bf16*)(ws + WS_WO + l * SZ_SQ), MP, D, D}; pg8::StaticOrder S; S.init(MP, D, G, c);
                pg8::EpiF32 E{Y, D};
                pg8::gemm_phase<pg8::EpiF32, pg8::StaticOrder, true, true>(lds, g, S, E);
            }
        }
        if (ph + 1 < a.ph_hi) grid.sync();
    }
}

#ifndef N_LAUNCHES
#define N_LAUNCHES 1
#endif
extern "C" void kernel_launch(void* const* d_in, const int* in_sizes, int n_in, void* d_out, int out_size, void* d_ws, size_t ws_size, hipStream_t stream) {
    static int grid = 0;
    if (grid == 0) {
        if (n_in != 12 || out_size != NTOK * D || ws_size < WS_END) { fprintf(stderr, "kernel_launch: unexpected problem (n_in %d out %d ws %zu need %zu)\n", n_in, out_size, ws_size, (size_t)WS_END); grid = -1; return; }
        int dev = 0, cus = 0, per_cu = 0;
        hipGetDevice(&dev);
        hipDeviceGetAttribute(&cus, hipDeviceAttributeMultiprocessorCount, dev);
        if (hipFuncSetAttribute((const void*)fwd_kernel, hipFuncAttributeMaxDynamicSharedMemorySize, LDS_BYTES) != hipSuccess) { fprintf(stderr, "kernel_launch: hipFuncSetAttribute failed\n"); grid = -1; return; }
        if (hipOccupancyMaxActiveBlocksPerMultiprocessor(&per_cu, (const void*)fwd_kernel, NTHR, LDS_BYTES) != hipSuccess || per_cu < 1) { fprintf(stderr, "kernel_launch: occupancy query says %d\n", per_cu); per_cu = 1; }
        (void)hipGetLastError();
        grid = cus;
        if (grid > cus * per_cu) grid = cus * per_cu;
    }
    if (grid < 0) return;
    Args a{};
    for (int i = 0; i < 12; ++i) a.in[i] = (const float*)d_in[i];
    a.out = (float*)d_out; a.ws = (unsigned char*)d_ws;
    for (int li = 0; li < N_LAUNCHES; ++li) {
        a.ph_lo = (N_LAUNCHES == 1) ? 0 : li; a.ph_hi = (N_LAUNCHES == 1) ? NPHASES : li + 1;
        void* args[] = {&a};
        hipError_t e = hipLaunchCooperativeKernel((const void*)fwd_kernel, dim3(grid), dim3(NTHR), args, LDS_BYTES, stream);
        if (e != hipSuccess) { fprintf(stderr, "cooperative launch failed: %s (grid %d)\n", hipGetErrorString(e), grid); break; }
    }
}
```

```cpp
#include <hip/hip_runtime.h>
#include <hip/hip_cooperative_groups.h>
#include <cstdio>
#include <cstdint>
namespace cg = cooperative_groups;
namespace pg8 {
#define PG8_LAS __attribute__((address_space(3)))
typedef unsigned short bf16_t;
typedef short bf16x8 __attribute__((ext_vector_type(8)));
typedef float f32x4 __attribute__((ext_vector_type(4)));
typedef unsigned u32x4 __attribute__((ext_vector_type(4)));
constexpr int BM = 256, BK = 64, HALF = 128, HTB = HALF * BK * 2  , STAGE_BYTES = 8 * HTB, NXCD = 8, WGM = 8;

__host__ __device__ __forceinline__ int lds_byte(int r, int c) { const int st = (r >> 4) * 2 + (c >> 5), rr = r & 15, cc = c & 31, ob = rr * 64 + cc * 2; return st * 1024 + (ob ^ (((ob >> 9) & 1) << 5)); }
__host__ __device__ __forceinline__ void stage_rc(int b, int& R, int& C) { const int st = b / 1024, sb = b % 1024, swz = sb ^ (((sb >> 9) & 1) << 5); R = (st >> 1) * 16 + swz / 64; C = (st & 1) * 32 + (swz % 64) / 2; }
__host__ __device__ __forceinline__ int perm32(int rho) { const int n = rho >> 4, i = rho & 15; return 8 * (i >> 2) + 4 * n + (i & 3); }

struct Unit { int pm, pn; };
struct Gemm { const bf16_t* A; const bf16_t* Bt; int M, N, K; };

struct StaticOrder {
    int nM, nN, nwg, G, c;
    __host__ __device__ void init(int M, int N, int G_, int c_) { nM = M / BM; nN = N / BM; nwg = nM * nN; G = G_; c = c_; }
    __host__ __device__ bool next(int i, Unit& u) const {
        const long L = (long)i * G + c; if (L >= nwg) return false;
        int wgid = (int)L; { const int q = nwg / NXCD, r = nwg % NXCD, xcd = wgid % NXCD, off = wgid / NXCD; wgid = (xcd < r ? xcd * (q + 1) : r * (q + 1) + (xcd - r) * q) + off; }
        const int nig = WGM * nN, gid = wgid / nig, fm = gid * WGM, gsz = (nM - fm) < WGM ? (nM - fm) : WGM;
        u.pm = fm + ((wgid % nig) % gsz); u.pn = (wgid % nig) / gsz; return true;
    }
    __device__ __forceinline__ void a_ready(const Unit&) const {}
    __device__ __forceinline__ void done(const Unit&) const {}
};
__device__ __forceinline__ unsigned cvt_pk_bf16(float lo, float hi) { unsigned r; asm volatile("v_cvt_pk_bf16_f32 %0, %1, %2" : "=v"(r) : "v"(lo), "v"(hi)); return r; }
typedef float f32x2 __attribute__((ext_vector_type(2)));
typedef unsigned u32x2 __attribute__((ext_vector_type(2)));
__device__ __forceinline__ float bf2f(unsigned short b) { return __uint_as_float(((unsigned)b) << 16); }
__device__ __forceinline__ float sigmoidf_fast(float x) { return __builtin_amdgcn_rcpf(1.0f + __builtin_amdgcn_exp2f(-1.4426950408889634f * x)); }
__device__ __forceinline__ float silu_mul(float g, float u) { return g * sigmoidf_fast(g) * u; }

struct EpiF32 {
    static constexpr bool PERM = false, AFTER_DRAIN = false;
    float* C; int ldc;
    __device__ __forceinline__ void operator()(const f32x4 (&acc)[2][2][4][2], const Unit& u, int wr, int wc, int fr, int fq) const {
        const int row0 = u.pm * BM + wr * 64 + fr, col0 = u.pn * BM + wc * 32 + 4 * fq;
#pragma unroll
        for (int ai = 0; ai < 2; ++ai)
#pragma unroll
            for (int m = 0; m < 4; ++m) { float* rowp = C + (size_t)(row0 + ai * HALF + m * 16) * ldc + col0;
#pragma unroll
                for (int bj = 0; bj < 2; ++bj)
#pragma unroll
                    for (int n = 0; n < 2; ++n) *(f32x4*)(rowp + bj * HALF + n * 16) = acc[ai][bj][m][n]; }
    }
};
struct EpiSwiglu {
    static constexpr bool PERM = true, AFTER_DRAIN = false;
    bf16_t* G; int ldc;
    __device__ __forceinline__ void operator()(const f32x4 (&acc)[2][2][4][2], const Unit& u, int wr, int wc, int fr, int fq) const {
        const int row0 = u.pm * BM + wr * 64 + fr, col0 = u.pn * HALF + wc * 32 + 8 * fq;
#pragma unroll
        for (int ai = 0; ai < 2; ++ai)
#pragma unroll
            for (int m = 0; m < 4; ++m) { bf16_t* rowp = G + (size_t)(row0 + ai * HALF + m * 16) * ldc + col0;
                const f32x4 g0 = acc[ai][0][m][0], g1 = acc[ai][0][m][1], u0 = acc[ai][1][m][0], u1 = acc[ai][1][m][1];
                u32x4 w;
                w.x = cvt_pk_bf16(silu_mul(g0[0], u0[0]), silu_mul(g0[1], u0[1]));
                w.y = cvt_pk_bf16(silu_mul(g0[2], u0[2]), silu_mul(g0[3], u0[3]));
                w.z = cvt_pk_bf16(silu_mul(g1[0], u1[0]), silu_mul(g1[1], u1[1]));
                w.w = cvt_pk_bf16(silu_mul(g1[2], u1[2]), silu_mul(g1[3], u1[3]));
                *(u32x4*)rowp = w; }
    }
};
struct EpiWin {
    static constexpr bool PERM = true, AFTER_DRAIN = false;
    bf16_t *U, *Q, *Kb, *Vb, *GP, *GA; float qscale;
    __device__ __forceinline__ void operator()(const f32x4 (&acc)[2][2][4][2], const Unit& u, int wr, int wc, int fr, int fq) const {
        bf16_t* base; int ldc, ct; float sc = 1.f; const int pn = u.pn;
        if (pn < 2) { base = U; ldc = 512; ct = pn; }
        else if (pn < 6) { base = Q; ldc = 1024; ct = pn - 2; sc = qscale; }
        else if (pn == 6) { base = Kb; ldc = 256; ct = 0; }
        else if (pn == 7) { base = Vb; ldc = 256; ct = 0; }
        else if (pn < 12) { base = GP; ldc = 1024; ct = pn - 8; }
        else { base = GA; ldc = 1024; ct = pn - 12; }
        const int row0 = u.pm * BM + wr * 64 + fr, col0 = ct * BM + wc * 32 + 8 * fq;
#pragma unroll
        for (int ai = 0; ai < 2; ++ai)
#pragma unroll
            for (int m = 0; m < 4; ++m) { bf16_t* rowp = base + (size_t)(row0 + ai * HALF + m * 16) * ldc + col0;
#pragma unroll
                for (int bj = 0; bj < 2; ++bj) { const f32x4 v0 = acc[ai][bj][m][0] * sc, v1 = acc[ai][bj][m][1] * sc;
                    u32x4 w; w.x = cvt_pk_bf16(v0[0], v0[1]); w.y = cvt_pk_bf16(v0[2], v0[3]); w.z = cvt_pk_bf16(v1[0], v1[1]); w.w = cvt_pk_bf16(v1[2], v1[3]);
                    *(u32x4*)(rowp + bj * HALF) = w; } }
    }
};
struct EpiPoolProj {
    static constexpr bool PERM = false, AFTER_DRAIN = false;
    float* T; const bf16_t* GP;
    __device__ __forceinline__ void operator()(const f32x4 (&acc)[2][2][4][2], const Unit& u, int wr, int wc, int fr, int fq) const {
        const int row0 = u.pm * BM + wr * 64 + fr, col0 = u.pn * BM + wc * 32 + 4 * fq;
#pragma unroll
        for (int ai = 0; ai < 2; ++ai)
#pragma unroll
            for (int m = 0; m < 4; ++m) { const size_t off = (size_t)(row0 + ai * HALF + m * 16) * 1024 + col0;
#pragma unroll
                for (int bj = 0; bj < 2; ++bj)
#pragma unroll
                    for (int n = 0; n < 2; ++n) { const size_t o2 = off + bj * HALF + n * 16; const u32x2 gw = *(const u32x2*)(GP + o2);
                        f32x4 g; g[0] = sigmoidf_fast(__uint_as_float(gw.x << 16)); g[1] = sigmoidf_fast(__uint_as_float(gw.x & 0xffff0000u));
                        g[2] = sigmoidf_fast(__uint_as_float(gw.y << 16)); g[3] = sigmoidf_fast(__uint_as_float(gw.y & 0xffff0000u));
                        *(f32x4*)(T + o2) = acc[ai][bj][m][n] * g; } }
    }
};
struct EpiAttnProj {
    static constexpr bool PERM = false, AFTER_DRAIN = false;
    const float* T; const bf16_t* GA; bf16_t* MG;
    __device__ __forceinline__ void operator()(const f32x4 (&acc)[2][2][4][2], const Unit& u, int wr, int wc, int fr, int fq) const {
        const int row0 = u.pm * BM + wr * 64 + fr, col0 = u.pn * BM + wc * 32 + 4 * fq;
#pragma unroll
        for (int ai = 0; ai < 2; ++ai)
#pragma unroll
            for (int m = 0; m < 4; ++m) { const size_t off = (size_t)(row0 + ai * HALF + m * 16) * 1024 + col0;
#pragma unroll
                for (int bj = 0; bj < 2; ++bj)
#pragma unroll
                    for (int n = 0; n < 2; ++n) { const size_t o2 = off + bj * HALF + n * 16; const u32x2 gw = *(const u32x2*)(GA + o2); const f32x4 t = *(const f32x4*)(T + o2);
                        f32x4 g; g[0] = sigmoidf_fast(__uint_as_float(gw.x << 16)); g[1] = sigmoidf_fast(__uint_as_float(gw.x & 0xffff0000u));
                        g[2] = sigmoidf_fast(__uint_as_float(gw.y << 16)); g[3] = sigmoidf_fast(__uint_as_float(gw.y & 0xffff0000u));
                        const f32x4 v = t + acc[ai][bj][m][n] * g;
                        u32x2 w; w.x = cvt_pk_bf16(v[0], v[1]); w.y = cvt_pk_bf16(v[2], v[3]);
                        *(u32x2*)(MG + o2) = w; } }
    }
};
template <class Epi, class Sched, bool ALIGN_EPI = false, bool SP2 = false>
__device__ __forceinline__ void gemm_phase(PG8_LAS unsigned char* lds, const Gemm g, const Sched& S, const Epi& E) {
    int tid_ = threadIdx.x; asm volatile("" : "+v"(tid_)); const int tid = tid_, wid = __builtin_amdgcn_readfirstlane(tid >> 6), lane = tid & 63, wr = wid >> 2, wc = wid & 3, fr = lane & 15, fq = lane >> 4;
    const int K = g.K, nt = K / BK;
    unsigned voffA[2], voffB[2];
#pragma unroll
    for (int i = 0; i < 2; ++i) { int R, C; stage_rc(tid * 16 + i * 8192, R, C); const int Rb = Epi::PERM ? ((R & ~31) + perm32(R & 31)) : R;
        voffA[i] = (unsigned)(R * K + C) * 2u; voffB[i] = (unsigned)(Rb * K + C) * 2u; }
    const size_t kstep = (size_t)(BK * 2);
    const size_t hstep = (size_t)HALF * K * 2;
    const size_t tstep = 2 * hstep;
    const unsigned ldsw = (unsigned)wid * 1024u;
    const int aoff = lds_byte(wr * 64 + fr, fq * 8), boff = lds_byte(wc * 32 + fr, fq * 8);
#define PG8_SA(b, h) (((b) * 2 + (h)) * HTB)
#define PG8_SB(b, h) ((4 + (b) * 2 + (h)) * HTB)
#define PG8_STAGE(bufoff, gbase, voff) do { _Pragma("unroll") for (int _i = 0; _i < 2; ++_i) \
        __builtin_amdgcn_global_load_lds((const unsigned*)((const char*)(gbase) + (voff)[_i]), (PG8_LAS unsigned*)(lds + (bufoff) + ldsw + _i * 8192), 16, 0, 0); } while (0)
#define PG8_LDA(dst, b, h) do { _Pragma("unroll") for (int m = 0; m < 4; ++m) _Pragma("unroll") for (int k = 0; k < 2; ++k) dst[m][k] = *(const PG8_LAS bf16x8*)(lds + PG8_SA(b, h) + aoff + m * 2048 + k * 1024); } while (0)
#define PG8_LDB(dst, b, h) do { _Pragma("unroll") for (int n = 0; n < 2; ++n) _Pragma("unroll") for (int k = 0; k < 2; ++k) dst[n][k] = *(const PG8_LAS bf16x8*)(lds + PG8_SB(b, h) + boff + n * 2048 + k * 1024); } while (0)
#define PG8_MMA(ai, bj, At, Bt) do { __builtin_amdgcn_s_setprio(1); _Pragma("unroll") for (int m = 0; m < 4; ++m) _Pragma("unroll") for (int n = 0; n < 2; ++n) _Pragma("unroll") for (int k = 0; k < 2; ++k) \
        acc[ai][bj][m][n] = __builtin_amdgcn_mfma_f32_16x16x32_bf16(Bt[n][k], At[m][k], acc[ai][bj][m][n], 0, 0, 0); __builtin_amdgcn_s_setprio(0); } while (0)
#define PG8_WAIT_V(n) asm volatile("s_waitcnt vmcnt(" #n ")" ::: "memory")
#define PG8_WAIT_L(n) asm volatile("s_waitcnt lgkmcnt(" #n ")" ::: "memory")
#define PG8_BAR __builtin_amdgcn_s_barrier()
#define PG8_SCHED __builtin_amdgcn_sched_barrier(0)
    Unit cur, nxt; int ui = 0;
    if (!S.next(0, cur)) return;
    f32x4 acc[2][2][4][2];
#pragma unroll
    for (int a = 0; a < 2; ++a)
#pragma unroll
        for (int b = 0; b < 2; ++b)
#pragma unroll
            for (int m = 0; m < 4; ++m)
#pragma unroll
                for (int n = 0; n < 2; ++n) acc[a][b][m][n] = (f32x4){0.f, 0.f, 0.f, 0.f};
    bf16x8 At[4][2], B0[2][2], B1[2][2];
    const char* cA = (const char*)g.A + (size_t)cur.pm * tstep; const char* cB = (const char*)g.Bt + (size_t)cur.pn * tstep;
    S.a_ready(cur);
    if constexpr (SP2) {
        PG8_STAGE(PG8_SB(0, 0), cB, voffB); PG8_STAGE(PG8_SB(0, 1), cB + hstep, voffB); PG8_STAGE(PG8_SA(0, 0), cA, voffA); PG8_STAGE(PG8_SA(0, 1), cA + hstep, voffA);
        if (wr == 1) PG8_BAR;
        PG8_WAIT_V(2); PG8_BAR;
        PG8_STAGE(PG8_SB(1, 0), cB + kstep, voffB); PG8_STAGE(PG8_SA(1, 0), cA + kstep, voffA); PG8_STAGE(PG8_SB(1, 1), cB + hstep + kstep, voffB);
        PG8_WAIT_V(6); PG8_BAR;
    } else {
        PG8_STAGE(PG8_SB(0, 0), cB, voffB); PG8_STAGE(PG8_SA(0, 0), cA, voffA); PG8_STAGE(PG8_SB(0, 1), cB + hstep, voffB); PG8_STAGE(PG8_SA(0, 1), cA + hstep, voffA);
        if (wr == 1) PG8_BAR;
        PG8_WAIT_V(4); PG8_BAR;
        PG8_STAGE(PG8_SB(1, 0), cB + kstep, voffB); PG8_STAGE(PG8_SA(1, 0), cA + kstep, voffA); PG8_STAGE(PG8_SB(1, 1), cB + hstep + kstep, voffB);
        PG8_WAIT_V(6); PG8_BAR;
    }
    for (;;) {
        const bool has_next = S.next(ui + 1, nxt);
        const char* nA = has_next ? (const char*)g.A + (size_t)nxt.pm * tstep : cA; const char* nB = has_next ? (const char*)g.Bt + (size_t)nxt.pn * tstep : cB;
        for (int t = 0; t < nt; t += 2) {
            const bool last = (t == nt - 2);
            const char* a1 = cA + (size_t)(t + 1) * kstep;
            const char* a2 = last ? nA : cA + (size_t)(t + 2) * kstep; const char* b2 = last ? nB : cB + (size_t)(t + 2) * kstep;
            const char* a3 = a2 + kstep; const char* b3 = b2 + kstep;
            if (last && has_next) S.a_ready(nxt);
            if constexpr (SP2) {
            PG8_LDB(B0, 0, 0); PG8_LDB(B1, 0, 1); PG8_SCHED; PG8_LDA(At, 0, 0); PG8_STAGE(PG8_SA(1, 1), a1 + hstep, voffA);
            PG8_WAIT_V(8); PG8_WAIT_L(0); PG8_BAR; PG8_MMA(0, 0, At, B0); PG8_MMA(0, 1, At, B1); PG8_BAR; PG8_SCHED;
            PG8_LDA(At, 0, 1); PG8_STAGE(PG8_SB(0, 0), b2, voffB); PG8_STAGE(PG8_SB(0, 1), b2 + hstep, voffB); PG8_STAGE(PG8_SA(0, 0), a2, voffA);
            PG8_WAIT_V(8); PG8_WAIT_L(0); PG8_BAR; PG8_MMA(1, 0, At, B0); PG8_MMA(1, 1, At, B1); PG8_BAR; PG8_SCHED;
            PG8_LDB(B0, 1, 0); PG8_LDB(B1, 1, 1); PG8_SCHED; PG8_LDA(At, 1, 0); PG8_STAGE(PG8_SA(0, 1), a2 + hstep, voffA);
            PG8_WAIT_V(8); PG8_WAIT_L(0); PG8_BAR; PG8_MMA(0, 0, At, B0); PG8_MMA(0, 1, At, B1); PG8_BAR; PG8_SCHED;
            PG8_LDA(At, 1, 1); PG8_STAGE(PG8_SB(1, 0), b3, voffB); PG8_STAGE(PG8_SB(1, 1), b3 + hstep, voffB); PG8_STAGE(PG8_SA(1, 0), a3, voffA);
            PG8_WAIT_V(8); PG8_WAIT_L(0); PG8_BAR; PG8_MMA(1, 0, At, B0); PG8_MMA(1, 1, At, B1); PG8_BAR; PG8_SCHED;
            } else {
            PG8_LDB(B0, 0, 0); PG8_SCHED; PG8_LDA(At, 0, 0); PG8_STAGE(PG8_SA(1, 1), a1 + hstep, voffA);
            PG8_WAIT_L(8); PG8_BAR; PG8_WAIT_L(0); PG8_MMA(0, 0, At, B0); PG8_BAR; PG8_SCHED;
            PG8_LDB(B1, 0, 1); PG8_STAGE(PG8_SB(0, 0), b2, voffB);
            PG8_BAR; PG8_WAIT_L(0); PG8_MMA(0, 1, At, B1); PG8_BAR;
            PG8_LDA(At, 0, 1); PG8_STAGE(PG8_SA(0, 0), a2, voffA);
            PG8_BAR; PG8_WAIT_L(0); PG8_MMA(1, 0, At, B0); PG8_BAR; PG8_SCHED;
            PG8_STAGE(PG8_SB(0, 1), b2 + hstep, voffB);
            PG8_WAIT_V(6); PG8_BAR; PG8_MMA(1, 1, At, B1); PG8_BAR;
            PG8_LDB(B0, 1, 0); PG8_SCHED; PG8_LDA(At, 1, 0); PG8_STAGE(PG8_SA(0, 1), a2 + hstep, voffA);
            PG8_WAIT_L(8); PG8_BAR; PG8_WAIT_L(0); PG8_MMA(0, 0, At, B0); PG8_BAR; PG8_SCHED;
            PG8_LDB(B1, 1, 1); PG8_STAGE(PG8_SB(1, 0), b3, voffB);
            PG8_BAR; PG8_WAIT_L(0); PG8_MMA(0, 1, At, B1); PG8_BAR;
            PG8_LDA(At, 1, 1); PG8_STAGE(PG8_SA(1, 0), a3, voffA);
            PG8_BAR; PG8_WAIT_L(0); PG8_MMA(1, 0, At, B0); PG8_BAR; PG8_SCHED;
            PG8_STAGE(PG8_SB(1, 1), b3 + hstep, voffB);
            PG8_WAIT_V(6); PG8_BAR; PG8_MMA(1, 1, At, B1); PG8_BAR;
            }
        }
        if constexpr (ALIGN_EPI) { if (wr == 0) PG8_BAR; }
        if constexpr (!Epi::AFTER_DRAIN) { E(acc, cur, wr, wc, fr, fq); S.done(cur); }
        if (!has_next) break;
#pragma unroll
        for (int a = 0; a < 2; ++a)
#pragma unroll
            for (int b = 0; b < 2; ++b)
#pragma unroll
                for (int m = 0; m < 4; ++m)
#pragma unroll
                    for (int n = 0; n < 2; ++n) acc[a][b][m][n] = (f32x4){0.f, 0.f, 0.f, 0.f};
        cur = nxt; cA = nA; cB = nB; ++ui;
        if constexpr (ALIGN_EPI) { if (wr == 1) PG8_BAR; }
    }
    PG8_WAIT_V(0);
    if constexpr (!ALIGN_EPI) { if (wr == 0) PG8_BAR; }
    PG8_BAR;
    if constexpr (Epi::AFTER_DRAIN) { E.fused(acc, cur, wr, wc, fr, fq, lds, wid, lane); S.done(cur); }
#undef PG8_SA
#undef PG8_SB
#undef PG8_STAGE
#undef PG8_LDA
#undef PG8_LDB
#undef PG8_MMA
#undef PG8_WAIT_V
#undef PG8_WAIT_L
#undef PG8_BAR
#undef PG8_SCHED
}
}

#define LAS __attribute__((address_space(3)))
typedef unsigned short bf16;
typedef unsigned v4u __attribute__((ext_vector_type(4)));
typedef unsigned v2u __attribute__((ext_vector_type(2)));
typedef float f32x4 __attribute__((ext_vector_type(4)));
typedef float f32x16 __attribute__((ext_vector_type(16)));
typedef short bf16x8 __attribute__((ext_vector_type(8)));
constexpr int NTOK = 16384, NMETA = 16, LTOT = NTOK + NMETA, MP = 16640, D = 1024, DFF = 2816, NIN = 4096;
constexpr float RMS_EPS = 1e-6f, LOG2E = 1.4426950408889634f;
constexpr int NWAVES = 8, NTHR = 512;
constexpr size_t MiB = 1u << 20;
constexpr size_t WS_HMETA = 512 * 1024;
constexpr size_t WS_WFI = 1 * MiB, SZ_WFI1 = (size_t)2 * DFF * D * 2;
constexpr size_t WS_WFO = WS_WFI + 4 * SZ_WFI1, SZ_WFO1 = (size_t)D * DFF * 2;
constexpr size_t WS_WIN = WS_WFO + 4 * SZ_WFO1, SZ_WIN1 = (size_t)NIN * D * 2;
constexpr size_t WS_WC = WS_WIN + 2 * SZ_WIN1, SZ_WC1 = (size_t)D * 512 * 2;
constexpr size_t WS_WAT = WS_WC + 2 * SZ_WC1, SZ_SQ = (size_t)D * D * 2;
constexpr size_t WS_WO = WS_WAT + 2 * SZ_SQ;
constexpr size_t SZ_ROWS_BF = (size_t)MP * D * 2;
constexpr size_t WS_XN = WS_WO + 2 * SZ_SQ;
constexpr size_t WS_Y = WS_XN + SZ_ROWS_BF;
constexpr size_t WS_ARENA = WS_Y + (size_t)MP * D * 4;
constexpr size_t WS_G = WS_ARENA;
constexpr size_t WS_U = WS_ARENA, WS_Q = WS_U + (size_t)MP * 512 * 2, WS_K = WS_Q + SZ_ROWS_BF, WS_V = WS_K + (size_t)MP * 256 * 2,
                 WS_GP = WS_V + (size_t)MP * 256 * 2, WS_GA = WS_GP + SZ_ROWS_BF, WS_PM = WS_GA + SZ_ROWS_BF, WS_END = WS_PM + (size_t)MP * 512 * 2;
static_assert(WS_G + (size_t)MP * DFF * 2 <= WS_END, "arena");
constexpr int LDS_BYTES = 131072 + 4096;

__device__ __forceinline__ float wave_sum(float v) {
#pragma unroll
    for (int o = 1; o < 64; o <<= 1) v += __shfl_xor(v, o);
    return v;
}
__device__ __forceinline__ unsigned pk2(float lo, float hi) { return pg8::cvt_pk_bf16(lo, hi); }
__device__ __forceinline__ float bflo(unsigned w) { return __uint_as_float(w << 16); }
__device__ __forceinline__ float bfhi(unsigned w) { return __uint_as_float(w & 0xffff0000u); }

__device__ __forceinline__ void transpose_item(const float* W, int K, int N, bf16* WT, int dst_row0, int k0, int n0, LAS float* scr, int lane) {
#pragma unroll 8
    for (int i = 0; i < 32; ++i) { const int kk = 2 * i + (lane >> 5); scr[kk * 33 + (lane & 31)] = W[(size_t)(k0 + kk) * N + n0 + (lane & 31)]; }
    asm volatile("s_waitcnt lgkmcnt(0)" ::: "memory");
    const int c = lane & 7;
#pragma unroll
    for (int j = 0; j < 4; ++j) { const int n = (lane >> 3) + 8 * j; const LAS float* s = scr + (8 * c) * 33 + n;
        v4u o; o.x = pk2(s[0 * 33], s[1 * 33]); o.y = pk2(s[2 * 33], s[3 * 33]); o.z = pk2(s[4 * 33], s[5 * 33]); o.w = pk2(s[6 * 33], s[7 * 33]);
        *(v4u*)(WT + (size_t)(dst_row0 + n) * K + k0 + 8 * c) = o; }
    asm volatile("s_waitcnt lgkmcnt(0)" ::: "memory");
}

struct Args { const float* in[12]; float* out; unsigned char* ws; int ph_lo, ph_hi; };

__device__ __forceinline__ void prologue(const Args& a, LAS unsigned char* lds, int wave, int lane, int tid) {
    unsigned char* ws = a.ws;
    LAS float* scr = (LAS float*)(lds + wave * 16384);
    const int G = gridDim.x, gw = blockIdx.x * NWAVES + wave, NGW = G * NWAVES;
    constexpr int I_FI = 16 * 176, I_FO = 44 * 32, I_WIN = 16 * 128, I_SQ = 16 * 32;
    constexpr int NITEMS = 4 * I_FI + 4 * I_FO + 2 * I_WIN + 4 * I_SQ;
    for (int it = gw; it < NITEMS; it += NGW) {
        int r = it;
        if (r < 4 * I_FI) { const int mi = r / I_FI; r -= mi * I_FI; const int kb = r / 176, nb = r % 176, n0 = nb * 32;
            const int j0 = n0 < DFF ? n0 : n0 - DFF; const int dst = (j0 >> 7) * 256 + (n0 < DFF ? 0 : 128) + (j0 & 127);
            transpose_item(a.in[3] + (size_t)mi * D * 2 * DFF, D, 2 * DFF, (bf16*)(ws + WS_WFI + mi * SZ_WFI1), dst, kb * 64, n0, scr, lane); continue; }
        r -= 4 * I_FI;
        if (r < 4 * I_FO) { const int mi = r / I_FO; r -= mi * I_FO; const int kb = r / 32, nb = r % 32;
            transpose_item(a.in[4] + (size_t)mi * DFF * D, DFF, D, (bf16*)(ws + WS_WFO + mi * SZ_WFO1), nb * 32, kb * 64, nb * 32, scr, lane); continue; }
        r -= 4 * I_FO;
        if (r < 2 * I_WIN) { const int mi = r / I_WIN; r -= mi * I_WIN; const int kb = r / 128, nb = r % 128;
            transpose_item(a.in[5] + (size_t)mi * D * NIN, D, NIN, (bf16*)(ws + WS_WIN + mi * SZ_WIN1), nb * 32, kb * 64, nb * 32, scr, lane); continue; }
        r -= 2 * I_WIN;
        { const int mi = r / I_SQ; r -= mi * I_SQ; const int kb = r / 32, nb = r % 32;
            const float* W = (mi < 2) ? a.in[10] + (size_t)mi * D * D : a.in[11] + (size_t)(mi - 2) * D * D;
            bf16* WT = (mi < 2) ? (bf16*)(ws + WS_WAT + mi * SZ_SQ) : (bf16*)(ws + WS_WO + (mi - 2) * SZ_SQ);
            transpose_item(W, D, D, WT, nb * 32, kb * 64, nb * 32, scr, lane); }
    }
    {
        const int gt = blockIdx.x * NTHR + tid, NT = G * NTHR;
        for (int it = gt; it < 2 * 64 * 1024; it += NT) {
            const int n = it & 1023, k8 = (it >> 10) & 63, l = it >> 16, g = k8 >> 4, c0 = (k8 & 15) * 8;
            const float* wg = a.in[6] + ((size_t)(l * 4 + g) * 128 + c0) * 128;
            const float* sc = a.in[7] + l * 512 + g * 128;
            const float* wp = a.in[8] + ((size_t)l * 512 + g * 128) * D + n;
            float acc[8];
#pragma unroll
            for (int i = 0; i < 8; ++i) acc[i] = 0.f;
            for (int d = 0; d < 128; ++d) { const float t = sc[d] * wp[(size_t)d * D];
#pragma unroll
                for (int i = 0; i < 8; ++i) acc[i] += wg[i * 128 + d] * t; }
            v4u o; o.x = pk2(acc[0], acc[1]); o.y = pk2(acc[2], acc[3]); o.z = pk2(acc[4], acc[5]); o.w = pk2(acc[6], acc[7]);
            *(v4u*)((bf16*)(ws + WS_WC + l * SZ_WC1) + (size_t)n * 512 + k8 * 8) = o;
        }
    }
    {
        const float* g = a.in[2];
        f32x4 gv[4];
#pragma unroll
        for (int j = 0; j < 4; ++j) gv[j] = *((const f32x4*)g + lane + 64 * j);
        for (int r = gw; r < NTOK; r += NGW) {
            const float* src = a.in[0] + (size_t)r * D;
            float* dst = a.out + (size_t)r * D;
            f32x4 v[4]; float ss = 0.f;
#pragma unroll
            for (int j = 0; j < 4; ++j) { v[j] = *((const f32x4*)src + lane + 64 * j); ss += (v[j].x * v[j].x + v[j].y * v[j].y) + (v[j].z * v[j].z + v[j].w * v[j].w); }
            const float rs = __builtin_amdgcn_rsqf(wave_sum(ss) * (1.f / D) + RMS_EPS);
            bf16* xn = (bf16*)(ws + WS_XN) + (size_t)r * D;
#pragma unroll
            for (int j = 0; j < 4; ++j) { *((f32x4*)dst + lane + 64 * j) = v[j]; const f32x4 o = v[j] * rs * gv[j];
                v2u w; w.x = pk2(o.x, o.y); w.y = pk2(o.z, o.w); *((v2u*)xn + lane + 64 * j) = w; }
        }
    }
}

__device__ __forceinline__ void rownorm_phase(const Args& a, const float* gpost, const float* gpre, float coef, bool last, int wave, int lane) {
    unsigned char* ws = a.ws;
    const int gw = blockIdx.x * NWAVES + wave, NGW = gridDim.x * NWAVES;
    f32x4 gp[4], gq[4];
#pragma unroll
    for (int j = 0; j < 4; ++j) { gp[j] = *((const f32x4*)gpost + lane + 64 * j) * coef; gq[j] = gpre ? *((const f32x4*)gpre + lane + 64 * j) : (f32x4){0.f, 0.f, 0.f, 0.f}; }
    for (int r = gw; r < NTOK; r += NGW) {
        float* h = a.out + (size_t)r * D;
        const float* y = (const float*)(ws + WS_Y) + (size_t)r * D;
        f32x4 yv[4], hv[4]; float ss = 0.f;
#pragma unroll
        for (int j = 0; j < 4; ++j) { yv[j] = *((const f32x4*)y + lane + 64 * j); hv[j] = *((const f32x4*)h + lane + 64 * j); ss += (yv[j].x * yv[j].x + yv[j].y * yv[j].y) + (yv[j].z * yv[j].z + yv[j].w * yv[j].w); }
        const float rs = __builtin_amdgcn_rsqf(wave_sum(ss) * (1.f / D) + RMS_EPS);
        float s2 = 0.f;
#pragma unroll
        for (int j = 0; j < 4; ++j) { hv[j] = hv[j] + yv[j] * rs * gp[j]; *((f32x4*)h + lane + 64 * j) = hv[j]; s2 += (hv[j].x * hv[j].x + hv[j].y * hv[j].y) + (hv[j].z * hv[j].z + hv[j].w * hv[j].w); }
        if (gpre) {
            const float r2 = __builtin_amdgcn_rsqf(wave_sum(s2) * (1.f / D) + RMS_EPS);
            bf16* xn = (bf16*)(ws + WS_XN) + (size_t)r * D;
#pragma unroll
            for (int j = 0; j < 4; ++j) { const f32x4 o = hv[j] * r2 * gq[j]; v2u w; w.x = pk2(o.x, o.y); w.y = pk2(o.z, o.w); *((v2u*)xn + lane + 64 * j) = w; }
        }
    }
}

constexpr int KS_PITCH = 144, VT_PITCH = 584, ATT_VT_OFF = 288 * KS_PITCH;
__device__ __forceinline__ int crow(int r, int hi) { return (r & 3) + 8 * (r >> 2) + 4 * hi; }

template <bool META>
__device__ __forceinline__ f32x16 attn_scores(LAS unsigned char* lds, const bf16x8 (&qf)[4], int tt, int sb, bool b0, float slope2, int i, int hi) {
    const float NEG = -1e30f;
    const int t = (tt < 5) ? sb + tt : 8;
    const LAS unsigned char* kb = lds + (32 * t + i) * KS_PITCH + hi * 16;
    f32x16 c = {};
#pragma unroll
    for (int d0 = 0; d0 < 4; ++d0) { const bf16x8 kf = *(const LAS bf16x8*)(kb + d0 * 32); c = __builtin_amdgcn_mfma_f32_32x32x16_bf16(kf, qf[d0], c, 0, 0, 0); }
    if (tt < 5) {
        const bool tile_ok = !(b0 && t < 4);
#pragma unroll
        for (int r = 0; r < 16; ++r) { const int dist = 128 - 32 * tt + i - crow(r, hi); const bool ok = tile_ok && dist >= 0 && dist <= 127; c[r] = ok ? c[r] - slope2 * (float)dist : NEG; }
    } else {
#pragma unroll
        for (int r = 0; r < 16; ++r) { const int cr = crow(r, hi); const bool ok = (cr < 16) && (!META || cr <= i); c[r] = ok ? c[r] : NEG; }
    }
    return c;
}
template <bool META>
__device__ __forceinline__ void attn_task(LAS unsigned char* lds, const bf16* Q, bf16* O, int qrow0, int h, int sb, bool b0, float slope2, float sink2, int lane) {
    const int i = lane & 31, hi = lane >> 5;
    const bf16* qp = Q + (size_t)(qrow0 + i) * D + h * 64 + hi * 8;
    bf16x8 qf[4];
#pragma unroll
    for (int d0 = 0; d0 < 4; ++d0) qf[d0] = *(const bf16x8*)(qp + d0 * 16);
    float m = sink2;
#pragma unroll 1
    for (int tt = META ? 5 : 0; tt < 6; ++tt) {
        const f32x16 c = attn_scores<META>(lds, qf, tt, sb, b0, slope2, i, hi);
#pragma unroll
        for (int r = 0; r < 16; ++r) m = fmaxf(m, c[r]);
    }
    m = fmaxf(m, __shfl_xor(m, 32));
    float s = 0.f;
    f32x16 o[2]; o[0] = f32x16{}; o[1] = f32x16{};
#pragma unroll 1
    for (int tt = META ? 5 : 0; tt < 6; ++tt) {
        f32x16 p = attn_scores<META>(lds, qf, tt, sb, b0, slope2, i, hi);
#pragma unroll
        for (int r = 0; r < 16; ++r) { p[r] = __builtin_amdgcn_exp2f(p[r] - m); s += p[r]; }
        const int t = (tt < 5) ? sb + tt : 8;
#pragma unroll
        for (int kb = 0; kb < 2; ++kb) {
            if (tt == 5 && kb == 1) break;
            v4u pw; pw.x = pk2(p[8 * kb + 0], p[8 * kb + 1]); pw.y = pk2(p[8 * kb + 2], p[8 * kb + 3]); pw.z = pk2(p[8 * kb + 4], p[8 * kb + 5]); pw.w = pk2(p[8 * kb + 6], p[8 * kb + 7]);
            const bf16x8 pb = __builtin_bit_cast(bf16x8, pw);
#pragma unroll
            for (int dh = 0; dh < 2; ++dh) {
                const LAS unsigned char* vp = lds + ATT_VT_OFF + (32 * dh + i) * VT_PITCH + (32 * t + 16 * kb + 4 * hi) * 2;
                const v2u lo = *(const LAS v2u*)vp, hi8 = *(const LAS v2u*)(vp + 16);
                v4u av; av.x = lo.x; av.y = lo.y; av.z = hi8.x; av.w = hi8.y;
                o[dh] = __builtin_amdgcn_mfma_f32_32x32x16_bf16(__builtin_bit_cast(bf16x8, av), pb, o[dh], 0, 0, 0);
            }
        }
    }
    s += __shfl_xor(s, 32);
    s += __builtin_amdgcn_exp2f(sink2 - m);
    const float inv = 1.0f / s;
    if (META && i >= 16) return;
    bf16* op = O + (size_t)(qrow0 + i) * D + h * 64 + 4 * hi;
#pragma unroll
    for (int dh = 0; dh < 2; ++dh)
#pragma unroll
        for (int r4 = 0; r4 < 4; ++r4) { v2u w; w.x = pk2(o[dh][4 * r4 + 0] * inv, o[dh][4 * r4 + 1] * inv); w.y = pk2(o[dh][4 * r4 + 2] * inv, o[dh][4 * r4 + 3] * inv);
            *(v2u*)(op + 32 * dh + 8 * r4) = w; }
}

__device__ __forceinline__ void attn_load(LAS unsigned char* lds, const bf16* Kb, const bf16* Vb, int blk, int kvh, int tid) {
    const bool meta = blk == 128;
    const v4u z = {0u, 0u, 0u, 0u};
    for (int item = tid + (meta ? 2048 : 0); item < 288 * 8; item += NTHR) {
        const int s = item >> 3, ch = item & 7;
        int row = -1;
        if (s < 256) { row = 128 * (blk - 1) + s; } else if (s < 272) row = NTOK + (s - 256);
        v4u v = z;
        if (row >= 0) v = *(const v4u*)(Kb + (size_t)row * 256 + kvh * 64 + ch * 8);
        *(LAS v4u*)(lds + s * KS_PITCH + ch * 16) = v;
    }
    for (int item = tid + (meta ? 1024 : 0); item < 144 * 8; item += NTHR) {
        const int kp = item >> 3, ch = item & 7, s = 2 * kp;
        int row = -1;
        if (s < 256) { row = 128 * (blk - 1) + s; } else if (s < 272) row = NTOK + (s - 256);
        v4u v0 = z, v1 = z;
        if (row >= 0) { v0 = *(const v4u*)(Vb + (size_t)row * 256 + kvh * 64 + ch * 8); v1 = *(const v4u*)(Vb + (size_t)(row + 1) * 256 + kvh * 64 + ch * 8); }
        LAS unsigned char* vt = lds + ATT_VT_OFF + (ch * 8) * VT_PITCH + kp * 4;
        *(LAS unsigned*)(vt + 0 * VT_PITCH) = (v0.x & 0xffffu) | (v1.x << 16);
        *(LAS unsigned*)(vt + 1 * VT_PITCH) = (v0.x >> 16) | (v1.x & 0xffff0000u);
        *(LAS unsigned*)(vt + 2 * VT_PITCH) = (v0.y & 0xffffu) | (v1.y << 16);
        *(LAS unsigned*)(vt + 3 * VT_PITCH) = (v0.y >> 16) | (v1.y & 0xffff0000u);
        *(LAS unsigned*)(vt + 4 * VT_PITCH) = (v0.z & 0xffffu) | (v1.z << 16);
        *(LAS unsigned*)(vt + 5 * VT_PITCH) = (v0.z >> 16) | (v1.z & 0xffff0000u);
        *(LAS unsigned*)(vt + 6 * VT_PITCH) = (v0.w & 0xffffu) | (v1.w << 16);
        *(LAS unsigned*)(vt + 7 * VT_PITCH) = (v0.w >> 16) | (v1.w & 0xffff0000u);
    }
}

__device__ __forceinline__ void mix_phase(const Args& a, int l, LAS unsigned char* lds, int wave, int lane, int tid) {
    unsigned char* ws = a.ws;
    const bf16* Kb = (const bf16*)(ws + WS_K); const bf16* Vb = (const bf16*)(ws + WS_V);
    bf16* Qb = (bf16*)(ws + WS_Q);
    const int G = gridDim.x;
    const float* sinks = a.in[9] + l * 16;
    for (int u = blockIdx.x; u < 512; u += G) {
        const int blk = u >> 2, kvh = u & 3;
        attn_load(lds, Kb, Vb, blk, kvh, tid);
        __syncthreads();
#pragma unroll 1
        for (int j = 0; j < 2; ++j) {
            const int task = wave * 2 + j, g = task >> 2, sb = task & 3, h = kvh * 4 + g;
            const float slope2 = exp2f(-0.5f * (float)(h + 1)) * LOG2E, sink2 = sinks[h] * LOG2E;
            attn_task<false>(lds, Qb, Qb, 128 * blk + 32 * sb, h, sb, blk == 0, slope2, sink2, lane);
        }
        __syncthreads();
    }
    if (blockIdx.x < 4) {
        const int kvh = blockIdx.x;
        attn_load(lds, Kb, Vb, 128, kvh, tid);
        __syncthreads();
        if (wave < 4) { const int h = kvh * 4 + wave; attn_task<true>(lds, Qb, Qb, NTOK, h, 0, false, 0.f, sinks[h] * LOG2E, lane); }
        __syncthreads();
    }
    {
        const bf16* U = (const bf16*)(ws + WS_U); bf16* PM = (bf16*)(ws + WS_PM);
        const int gt = blockIdx.x * NTHR + tid, NT = G * NTHR;
        for (int item = gt; item < LTOT * 64; item += NT) {
            const int pos = item >> 6, c8 = item & 63, w = 2 << (c8 >> 4), cnt = (pos + 1 < w) ? pos + 1 : w;
            float acc[8], self[8];
#pragma unroll
            for (int e = 0; e < 8; ++e) acc[e] = 0.f;
            for (int k = 0; k < cnt; ++k) { const int pp = pos - k, rr = pp < NMETA ? NTOK + pp : pp - NMETA;
                const v4u v = *(const v4u*)(U + (size_t)rr * 512 + c8 * 8);
                const float f[8] = {bflo(v.x), bfhi(v.x), bflo(v.y), bfhi(v.y), bflo(v.z), bfhi(v.z), bflo(v.w), bfhi(v.w)};
#pragma unroll
                for (int e = 0; e < 8; ++e) { acc[e] += f[e]; if (k == 0) self[e] = f[e]; } }
            const float ic = 1.0f / (float)cnt;
            const int row = pos < NMETA ? NTOK + pos : pos - NMETA;
            v4u o; o.x = pk2(acc[0] * ic - self[0], acc[1] * ic - self[1]); o.y = pk2(acc[2] * ic - self[2], acc[3] * ic - self[3]);
            o.z = pk2(acc[4] * ic - self[4], acc[5] * ic - self[5]); o.w = pk2(acc[6] * ic - self[6], acc[7] * ic - self[7]);
            *(v4u*)(PM + (size_t)row * 512 + c8 * 8) = o;
        }
    }
}

constexpr size_t WS_HM = 0;
constexpr size_t WS_YM1 = WS_END;
constexpr size_t WS_YM2 = WS_YM1 + 16 * 5632 * 4;
constexpr size_t WS_YM3 = WS_YM2 + 16 * 1024 * 4;
constexpr size_t WS_YMM = WS_YM3 + 16 * 1024 * 4;
constexpr size_t WS_END2 = WS_YMM + 16 * 1024 * 4;
constexpr int THIN_RED = 98304;
__device__ __forceinline__ int thin_pitch(int K) { return 2 * K + 16; }

__device__ __forceinline__ void thin_build_norm(LAS unsigned char* lds, const float* h_in, const float* Y, const float* gpost, float coef, const float* gpre, float* h_out, int wave, int lane) {
    const int pitch = thin_pitch(D);
#pragma unroll 1
    for (int rr = 0; rr < 2; ++rr) {
        const int r = 2 * wave + rr;
        f32x4 hv[4]; float s2 = 0.f;
#pragma unroll
        for (int j = 0; j < 4; ++j) hv[j] = *((const f32x4*)(h_in + (size_t)r * D) + lane + 64 * j);
        if (Y) {
            f32x4 yv[4]; float ss = 0.f;
#pragma unroll
            for (int j = 0; j < 4; ++j) { yv[j] = *((const f32x4*)(Y + (size_t)r * D) + lane + 64 * j); ss += (yv[j].x * yv[j].x + yv[j].y * yv[j].y) + (yv[j].z * yv[j].z + yv[j].w * yv[j].w); }
            const float rs = __builtin_amdgcn_rsqf(wave_sum(ss) * (1.f / D) + RMS_EPS) * coef;
#pragma unroll
            for (int j = 0; j < 4; ++j) { hv[j] = hv[j] + yv[j] * rs * *((const f32x4*)gpost + lane + 64 * j); if (h_out && blockIdx.x == 0) *((f32x4*)(h_out + (size_t)r * D) + lane + 64 * j) = hv[j]; }
        }
#pragma unroll
        for (int j = 0; j < 4; ++j) s2 += (hv[j].x * hv[j].x + hv[j].y * hv[j].y) + (hv[j].z * hv[j].z + hv[j].w * hv[j].w);
        const float r2 = __builtin_amdgcn_rsqf(wave_sum(s2) * (1.f / D) + RMS_EPS);
#pragma unroll
        for (int j = 0; j < 4; ++j) { const f32x4 o = hv[j] * r2 * *((const f32x4*)gpre + lane + 64 * j); v2u w; w.x = pk2(o.x, o.y); w.y = pk2(o.z, o.w);
            *(LAS v2u*)(lds + r * pitch + (4 * lane + 256 * j) * 2) = w; }
    }
    __syncthreads();
}
__device__ __forceinline__ void thin_build_swiglu(LAS unsigned char* lds, const float* YM1, int tid) {
    const int pitch = thin_pitch(DFF);
    for (int item = tid; item < 16 * (DFF / 4); item += NTHR) {
        const int r = item / (DFF / 4), j = (item % (DFF / 4)) * 4;
        const float* gp = YM1 + (size_t)r * (2 * DFF) + (j >> 7) * 256 + (j & 127);
        const f32x4 g = *(const f32x4*)gp, u = *(const f32x4*)(gp + 128);
        v2u w; w.x = pk2(pg8::silu_mul(g.x, u.x), pg8::silu_mul(g.y, u.y)); w.y = pk2(pg8::silu_mul(g.z, u.z), pg8::silu_mul(g.w, u.w));
        *(LAS v2u*)(lds + r * pitch + j * 2) = w;
    }
    __syncthreads();
}
__device__ __forceinline__ void thin_build_copy(LAS unsigned char* lds, const bf16* src, int K, int tid) {
    const int pitch = thin_pitch(K), cpr = K / 8;
    for (int item = tid; item < 16 * cpr; item += NTHR) { const int r = item / cpr, ch = item % cpr;
        *(LAS v4u*)(lds + r * pitch + ch * 16) = *(const v4u*)(src + (size_t)(NTOK + r) * K + ch * 8); }
    __syncthreads();
}
__device__ __forceinline__ void thin_build_f32(LAS unsigned char* lds, const float* src, int tid) {
    const int pitch = thin_pitch(D);
    for (int item = tid; item < 16 * (D / 4); item += NTHR) { const int r = item / (D / 4), j = (item % (D / 4)) * 4; const f32x4 v = *(const f32x4*)(src + (size_t)r * D + j);
        v2u w; w.x = pk2(v.x, v.y); w.y = pk2(v.z, v.w); *(LAS v2u*)(lds + r * pitch + j * 2) = w; }
    __syncthreads();
}
struct ThinRaw { float* Yo; int ldo; __device__ __forceinline__ void operator()(int r, int col, float v) const { Yo[(size_t)r * ldo + col] = v; } };
struct ThinWin { unsigned char* ws; float qscale;
    __device__ __forceinline__ void operator()(int r, int col, float v) const {
        bf16* base; int ld, c;
        if (col < 512) { base = (bf16*)(ws + WS_U); ld = 512; c = col; }
        else if (col < 1536) { base = (bf16*)(ws + WS_Q); ld = 1024; c = col - 512; v *= qscale; }
        else if (col < 1792) { base = (bf16*)(ws + WS_K); ld = 256; c = col - 1536; }
        else if (col < 2048) { base = (bf16*)(ws + WS_V); ld = 256; c = col - 1792; }
        else if (col < 3072) { base = (bf16*)(ws + WS_GP); ld = 1024; c = col - 2048; }
        else { base = (bf16*)(ws + WS_GA); ld = 1024; c = col - 3072; }
        base[(size_t)(NTOK + r) * ld + c] = (bf16)(pk2(v, 0.f) & 0xffffu);
    } };
struct ThinGate { float* T; const bf16* Gt; bool add;
    __device__ __forceinline__ void operator()(int r, int col, float v) const {
        const float g = pg8::sigmoidf_fast(pg8::bf2f(Gt[(size_t)(NTOK + r) * D + col])); float* t = T + (size_t)r * D + col; *t = (add ? *t : 0.f) + g * v; } };

template <class Epi>
__device__ __forceinline__ void thin_gemm(LAS unsigned char* lds, const bf16* Bt, int N, int K, const Epi& E, int wave, int lane) {
    const int pitch = thin_pitch(K), ks = K / 8, nst = K / 256, G = gridDim.x;
    for (int cgp = blockIdx.x; cgp < N / 16; cgp += G) {
        const bf16* bp = Bt + (size_t)(cgp * 16 + (lane & 15)) * K + wave * ks + 8 * (lane >> 4);
        const LAS unsigned char* ap = lds + (lane & 15) * pitch + (wave * ks + 8 * (lane >> 4)) * 2;
        f32x4 acc = {0.f, 0.f, 0.f, 0.f};
        for (int s = 0; s < nst; ++s) { const bf16x8 b = *(const bf16x8*)(bp + 32 * s); const bf16x8 av = *(const LAS bf16x8*)(ap + 64 * s);
            acc = __builtin_amdgcn_mfma_f32_16x16x32_bf16(av, b, acc, 0, 0, 0); }
        *(LAS f32x4*)(lds + THIN_RED + (wave * 64 + lane) * 16) = acc;
        __syncthreads();
        if (wave == 0) {
            f32x4 t = acc;
#pragma unroll
            for (int w = 1; w < 8; ++w) t = t + *(const LAS f32x4*)(lds + THIN_RED + (w * 64 + lane) * 16);
            const int col = cgp * 16 + (lane & 15), r0 = 4 * (lane >> 4);
            E(r0 + 0, col, t.x); E(r0 + 1, col, t.y); E(r0 + 2, col, t.z); E(r0 + 3, col, t.w);
        }
        __syncthreads();
    }
}

constexpr int NPHASES = 23;
__global__ void __launch_bounds__(NTHR, 2) fwd_kernel(Args a) {
    extern __shared__ __attribute__((aligned(16))) unsigned char lds_raw[];
    LAS unsigned char* lds = (LAS unsigned char*)lds_raw;
    cg::grid_group grid = cg::this_grid();
    unsigned char* ws = a.ws;
    const int G = gridDim.x, c = blockIdx.x;
    bf16* XN = (bf16*)(ws + WS_XN); float* Y = (float*)(ws + WS_Y);
#pragma unroll 1
    for (int ph = a.ph_lo; ph < a.ph_hi; ++ph) {
        int t_ = threadIdx.x; asm volatile("" : "+v"(t_)); const int tid = t_, lane = tid & 63, wave = __builtin_amdgcn_readfirstlane(tid >> 6);
        if (ph == 0) prologue(a, lds, wave, lane, tid);
        else {
            const int l = (ph - 1) / 11, k = (ph - 1) % 11;
            const float* ng = a.in[2] + (size_t)l * 6 * D;
            const float* ng0 = a.in[2];
            float* HM = (float*)(ws + WS_HM); float* YM1 = (float*)(ws + WS_YM1); float* YM2 = (float*)(ws + WS_YM2); float* YM3 = (float*)(ws + WS_YM3); float* YMM = (float*)(ws + WS_YMM);
            if (k == 0 || k == 8) {
                const int mi = l * 2 + (k == 8);
                const bf16* Wt = (const bf16*)(ws + WS_WFI + mi * SZ_WFI1);
                if (c < 352 && !(l == 1 && k == 8)) {
                    if (k == 0) { if (l == 0) thin_build_norm(lds, a.in[1], nullptr, nullptr, 0.f, ng, nullptr, wave, lane);
                                  else thin_build_norm(lds, HM + 1 * 16 * D, YM2, ng0 + 5 * D, 0.5f, ng, HM + 2 * 16 * D, wave, lane); }
                    else thin_build_norm(lds, HM, YM3, ng + 3 * D, 1.0f, ng + 4 * D, HM + 1 * 16 * D, wave, lane);
                    thin_gemm(lds, Wt, 2 * DFF, D, ThinRaw{YM1, 2 * DFF}, wave, lane);
                }
                pg8::Gemm g{XN, Wt, NTOK, 2 * DFF, D}; pg8::StaticOrder S; S.init(NTOK, 2 * DFF, G, c);
                pg8::EpiSwiglu E{(bf16*)(ws + WS_G), DFF};
                pg8::gemm_phase<pg8::EpiSwiglu, pg8::StaticOrder, true, true>(lds, g, S, E);
            } else if (k == 1 || k == 9) {
                const int mi = l * 2 + (k == 9);
                const bf16* Wt = (const bf16*)(ws + WS_WFO + mi * SZ_WFO1);
                if (c < 64 && !(l == 1 && k == 9)) { thin_build_swiglu(lds, YM1, tid); thin_gemm(lds, Wt, D, DFF, ThinRaw{YM2, D}, wave, lane); }
                pg8::Gemm g{(const bf16*)(ws + WS_G), Wt, NTOK, D, DFF}; pg8::StaticOrder S; S.init(NTOK, D, G, c);
                pg8::EpiF32 E{Y, D};
                pg8::gemm_phase<pg8::EpiF32, pg8::StaticOrder, true, true>(lds, g, S, E);
            } else if (k == 2) rownorm_phase(a, ng + 1 * D, ng + 2 * D, 0.5f, false, wave, lane);
            else if (k == 7) rownorm_phase(a, ng + 3 * D, ng + 4 * D, 1.0f, false, wave, lane);
            else if (k == 10) rownorm_phase(a, ng + 5 * D, l == 0 ? ng + 6 * D : nullptr, 0.5f, l == 1, wave, lane);
            else if (k == 3) {
                const bf16* Wt = (const bf16*)(ws + WS_WIN + l * SZ_WIN1);
                if (c < 256) {
                    if (l == 0) thin_build_norm(lds, a.in[1], YM2, ng + 1 * D, 0.5f, ng + 2 * D, HM, wave, lane);
                    else thin_build_norm(lds, HM + 2 * 16 * D, YM2, ng + 1 * D, 0.5f, ng + 2 * D, nullptr, wave, lane);
                    thin_gemm(lds, Wt, NIN, D, ThinWin{ws, 0.125f * LOG2E}, wave, lane);
                }
                pg8::Gemm g{XN, Wt, NTOK, NIN, D}; pg8::StaticOrder S; S.init(NTOK, NIN, G, c);
                pg8::EpiWin E{(bf16*)(ws + WS_U), (bf16*)(ws + WS_Q), (bf16*)(ws + WS_K), (bf16*)(ws + WS_V), (bf16*)(ws + WS_GP), (bf16*)(ws + WS_GA), 0.125f * LOG2E};
                pg8::gemm_phase<pg8::EpiWin, pg8::StaticOrder, true, true>(lds, g, S, E);
            } else if (k == 4) mix_phase(a, l, lds, wave, lane, tid);
            else if (k == 5) {
                if (c < 64 && l == 0) {
                    thin_build_copy(lds, (const bf16*)(ws + WS_PM), 512, tid);
                    thin_gemm(lds, (const bf16*)(ws + WS_WC + l * SZ_WC1), D, 512, ThinGate{YMM, (const bf16*)(ws + WS_GP), false}, wave, lane);
                    thin_build_copy(lds, (const bf16*)(ws + WS_Q), D, tid);
                    thin_gemm(lds, (const bf16*)(ws + WS_WAT + l * SZ_SQ), D, D, ThinGate{YMM, (const bf16*)(ws + WS_GA), true}, wave, lane);
                }
                { pg8::Gemm g{(const bf16*)(ws + WS_PM), (const bf16*)(ws + WS_WC + l * SZ_WC1), NTOK, D, 512}; pg8::StaticOrder S; S.init(NTOK, D, G, c);
                  pg8::EpiPoolProj E{Y, (const bf16*)(ws + WS_GP)};
                  pg8::gemm_phase<pg8::EpiPoolProj, pg8::StaticOrder, true, true>(lds, g, S, E); }
                { pg8::Gemm g{(const bf16*)(ws + WS_Q), (const bf16*)(ws + WS_WAT + l * SZ_SQ), NTOK, D, D}; pg8::StaticOrder S; S.init(NTOK, D, G, c);
                  pg8::EpiAttnProj E{Y, (const bf16*)(ws + WS_GA), XN};
                  pg8::gemm_phase<pg8::EpiAttnProj, pg8::StaticOrder, true, true>(lds, g, S, E); }
            } else if (k == 6) {
                const bf16* Wt = (const bf16*)(ws + WS_WO + l * SZ_SQ);
                if (c < 64 && l == 0) { thin_build_f32(lds, YMM, tid); thin_gemm(lds, Wt, D, D, ThinRaw{YM3, D}, wave, lane); }
                pg8::Gemm g{XN, Wt, NTOK, D, D}; pg8::StaticOrder S; S.init(NTOK, D, G, c);
                pg8::EpiF32 E{Y, D};
                pg8::gemm_phase<pg8::EpiF32, pg8::StaticOrder, true, true>(lds, g, S, E);
            }
        }
        if (ph + 1 < a.ph_hi) grid.sync();
    }
}

#ifndef N_LAUNCHES
#define N_LAUNCHES 1
#endif
extern "C" void kernel_launch(void* const* d_in, const int* in_sizes, int n_in, void* d_out, int out_size, void* d_ws, size_t ws_size, hipStream_t stream) {
    static int grid = 0;
    if (grid == 0) {
        if (n_in != 12 || out_size != NTOK * D || ws_size < WS_END2) { fprintf(stderr, "kernel_launch: unexpected problem (n_in %d out %d ws %zu need %zu)\n", n_in, out_size, ws_size, (size_t)WS_END2); grid = -1; return; }
        int dev = 0, cus = 0, per_cu = 0;
        hipGetDevice(&dev);
        hipDeviceGetAttribute(&cus, hipDeviceAttributeMultiprocessorCount, dev);
        if (hipFuncSetAttribute((const void*)fwd_kernel, hipFuncAttributeMaxDynamicSharedMemorySize, LDS_BYTES) != hipSuccess) { fprintf(stderr, "kernel_launch: hipFuncSetAttribute failed\n"); grid = -1; return; }
        if (hipOccupancyMaxActiveBlocksPerMultiprocessor(&per_cu, (const void*)fwd_kernel, NTHR, LDS_BYTES) != hipSuccess || per_cu < 1) { fprintf(stderr, "kernel_launch: occupancy query says %d\n", per_cu); per_cu = 1; }
        (void)hipGetLastError();
        grid = cus;
        if (grid > cus * per_cu) grid = cus * per_cu;
    }
    if (grid < 0) return;
    Args a{};
    for (int i = 0; i < 12; ++i) a.in[i] = (const float*)d_in[i];
    a.out = (float*)d_out; a.ws = (unsigned char*)d_ws;
    for (int li = 0; li < N_LAUNCHES; ++li) {
        a.ph_lo = (N_LAUNCHES == 1) ? 0 : li; a.ph_hi = (N_LAUNCHES == 1) ? NPHASES : li + 1;
        void* args[] = {&a};
        hipError_t e = hipLaunchCooperativeKernel((const void*)fwd_kernel, dim3(grid), dim3(NTHR), args, LDS_BYTES, stream);
        if (e != hipSuccess) { fprintf(stderr, "cooperative launch failed: %s (grid %d)\n", hipGetErrorString(e), grid); break; }
    }
}
```
